# Optimizing an MI355X kernel written in HIP

```python
import jax, jax.numpy as jnp
from jax import lax
import numpy as np

D_MODEL = 1024
BATCH = 8
SEQ = 2048
DEPTH = 1

MIX_DIM = D_MODEL
HEAD_DIM = 64
ATTN_DIM = MIX_DIM // 2
N_ATTN_HEADS = ATTN_DIM // HEAD_DIM
POOL_DIM = MIX_DIM - ATTN_DIM
POOL_WINDOWS = (2, 4, 8, 16)
N_POOL_GROUPS = len(POOL_WINDOWS)
POOL_GROUP_DIM = POOL_DIM // N_POOL_GROUPS
Q_BLOCK = 128
IN_DIM = POOL_DIM + 3 * ATTN_DIM + N_ATTN_HEADS
N_EXPERT_GROUPS = 4
EXPERTS_PER_GROUP = 8
TOP_K = 2
D_EXPERT = D_MODEL // 2
PLE_DIM = 256
EPS = 1e-6

kernel_name = "hybrid_pool_fox_hmoe_ple"


def rms_norm(x, g):
    xf = x.astype(jnp.float32)
    y = xf * lax.rsqrt(jnp.mean(xf * xf, axis=-1, keepdims=True) + EPS)
    return (y * g.astype(jnp.float32)).astype(x.dtype)


def causal_pool_mixer(u, w_pool, s_pool):
    B, S, _ = u.shape
    ug = u.reshape(B, S, N_POOL_GROUPS, POOL_GROUP_DIM)
    cs = jnp.cumsum(ug.astype(jnp.float32), axis=1)
    pos = jnp.arange(1, S + 1, dtype=jnp.float32)
    means = []
    for gi, w in enumerate(POOL_WINDOWS):
        c = cs[:, :, gi]
        lag = jnp.pad(c, ((0, 0), (w, 0), (0, 0)))[:, :S]
        cnt = jnp.minimum(pos, jnp.float32(w))[None, :, None]
        means.append((c - lag) / cnt)
    mean = jnp.stack(means, axis=2)
    d = (mean - ug.astype(jnp.float32)).astype(u.dtype)
    y = jnp.einsum('bsgc,gcd->bsgd', d, w_pool)
    return y.reshape(B, S, POOL_DIM) * s_pool


def forgetting_attention(q, k, v, log_f):
    B, S, H, Dh = q.shape
    c = jnp.cumsum(log_f.astype(jnp.float32), axis=1).transpose(0, 2, 1)
    qf = q.astype(jnp.float32).transpose(0, 2, 1, 3) * (Dh ** -0.5)
    kf = k.astype(jnp.float32).transpose(0, 2, 1, 3)
    vt = v.transpose(0, 2, 1, 3)
    tri = jnp.tril(jnp.ones((Q_BLOCK, Q_BLOCK), dtype=bool))
    outs = []
    for i in range(S // Q_BLOCK):
        q0, q1 = i * Q_BLOCK, (i + 1) * Q_BLOCK
        s = jnp.einsum('bhqd,bhkd->bhqk', qf[:, :, q0:q1], kf[:, :, :q1])
        s = s + (c[:, :, q0:q1, None] - c[:, :, None, :q1])
        mask = jnp.concatenate([jnp.ones((Q_BLOCK, q0), dtype=bool), tri], axis=1)
        s = jnp.where(mask, s, -jnp.inf)
        pr = jax.nn.softmax(s, axis=-1)
        outs.append(jnp.einsum('bhqk,bhkd->bhqd', pr.astype(v.dtype), vt[:, :, :q1]))
    o = jnp.concatenate(outs, axis=2)
    return o.transpose(0, 2, 1, 3).reshape(B, S, H * Dh)


def hierarchical_moe(m, w_grp, b_grp, w_rt, b_rt, w_e_gate, w_e_up, w_e_down):
    B, S, D = m.shape
    G, E = N_EXPERT_GROUPS, EXPERTS_PER_GROUP
    t = m.reshape(-1, D)
    grp_prob = jax.nn.softmax((t @ w_grp + b_grp).astype(jnp.float32), axis=-1)
    g_idx = jnp.argmax(grp_prob, axis=-1)
    g_w = jnp.max(grp_prob, axis=-1)
    ex_logits = (t @ w_rt + b_rt).astype(jnp.float32).reshape(-1, G, E)
    sel = jnp.take_along_axis(ex_logits, g_idx[:, None, None], axis=1)[:, 0]
    top_v, top_i = lax.top_k(sel, TOP_K)
    top_w = jax.nn.softmax(top_v, axis=-1) * g_w[:, None]
    e_comb = jnp.sum(jax.nn.one_hot(top_i, E, dtype=jnp.float32) * top_w[..., None], axis=1)
    comb = (jax.nn.one_hot(g_idx, G, dtype=jnp.float32)[:, :, None] * e_comb[:, None, :]).astype(t.dtype)
    y = jnp.zeros_like(t)
    for g in range(G):
        hg = jnp.einsum('nd,edf->nef', t, w_e_gate[g])
        hu = jnp.einsum('nd,edf->nef', t, w_e_up[g])
        a = jax.nn.silu(hg) * hu * comb[:, g, :, None]
        y = y + jnp.einsum('nef,efd->nd', a, w_e_down[g])
    return y.reshape(B, S, D)


def setup_inputs(seed: int = 0) -> dict:
    key = jax.random.key(seed)
    ks = jax.random.split(key, 24)
    L, D, H = DEPTH, D_MODEL, N_ATTN_HEADS
    G, E, F = N_EXPERT_GROUPS, EXPERTS_PER_GROUP, D_EXPERT
    nrm = lambda k, shape, fan_in: jax.random.normal(k, shape, jnp.float32) * (fan_in ** -0.5)
    gain = lambda k, shape: 1.0 + 0.02 * jax.random.normal(k, shape, jnp.float32)
    return {
        "x": jax.random.normal(ks[0], (BATCH, SEQ, D), jnp.float32),
        "p": jax.random.normal(ks[1], (L, BATCH, SEQ, PLE_DIM), jnp.float32),
        "g_mix": gain(ks[2], (L, D)),
        "w_in": nrm(ks[3], (L, D, IN_DIM), D),
        "b_f": jnp.linspace(1.0, 4.0, H, dtype=jnp.float32)[None, :] + 0.1 * jax.random.normal(ks[4], (L, H), jnp.float32),
        "w_pool": nrm(ks[5], (L, N_POOL_GROUPS, POOL_GROUP_DIM, POOL_GROUP_DIM), POOL_GROUP_DIM),
        "s_pool": gain(ks[6], (L, POOL_DIM)),
        "w_out": nrm(ks[7], (L, MIX_DIM, D), MIX_DIM),
        "g_ffn": gain(ks[8], (L, D)),
        "w_grp": nrm(ks[9], (L, D, G), D),
        "b_grp": 0.01 * jax.random.normal(ks[10], (L, G), jnp.float32),
        "w_rt": nrm(ks[11], (L, D, G * E), D),
        "b_rt": 0.01 * jax.random.normal(ks[12], (L, G * E), jnp.float32),
        "w_e_gate": nrm(ks[13], (L, G, E, D, F), D),
        "w_e_up": nrm(ks[14], (L, G, E, D, F), D),
        "w_e_down": nrm(ks[15], (L, G, E, F, D), F),
        "g_ple": gain(ks[16], (L, D)),
        "w_ple_gate": nrm(ks[17], (L, D, D), D),
        "w_ple_proj": nrm(ks[18], (L, PLE_DIM, D), PLE_DIM),
        "g_final": gain(ks[19], (D,)),
    }


def reference(x, p, g_mix, w_in, b_f, w_pool, s_pool, w_out, g_ffn, w_grp, b_grp,
              w_rt, b_rt, w_e_gate, w_e_up, w_e_down, g_ple, w_ple_gate, w_ple_proj, g_final):
    B, S, D = x.shape
    H = N_ATTN_HEADS
    h = x
    for i in range(DEPTH):
        a = rms_norm(h, g_mix[i])
        z = a @ w_in[i]
        o0 = POOL_DIM
        u_pool = z[..., :o0]
        q = z[..., o0:o0 + ATTN_DIM].reshape(B, S, H, HEAD_DIM)
        k = z[..., o0 + ATTN_DIM:o0 + 2 * ATTN_DIM].reshape(B, S, H, HEAD_DIM)
        v = z[..., o0 + 2 * ATTN_DIM:o0 + 3 * ATTN_DIM].reshape(B, S, H, HEAD_DIM)
        f_logit = z[..., o0 + 3 * ATTN_DIM:] + b_f[i]
        log_f = jax.nn.log_sigmoid(f_logit.astype(jnp.float32))
        pool_out = causal_pool_mixer(u_pool, w_pool[i], s_pool[i])
        attn_out = forgetting_attention(q, k, v, log_f).astype(h.dtype)
        h = h + jnp.concatenate([pool_out, attn_out], axis=-1) @ w_out[i]
        h = h + hierarchical_moe(rms_norm(h, g_ffn[i]), w_grp[i], b_grp[i], w_rt[i], b_rt[i],
                                 w_e_gate[i], w_e_up[i], w_e_down[i])
        gate = jax.nn.sigmoid(rms_norm(h, g_ple[i]) @ w_ple_gate[i])
        h = h + gate * (p[i] @ w_ple_proj[i])
    return rms_norm(h, g_final)
```

```cpp
#include <hip/hip_runtime.h>
#include <cstdio>
#include <cstdint>

constexpr int D_MODEL = 1024, BATCH = 8, SEQ = 2048, NTOK = BATCH * SEQ;
constexpr int HEAD_DIM = 64, ATTN_DIM = 512, NH = 8, POOL_DIM = 512, PGD = 128, IN_DIM = 2056;
constexpr int NG = 4, EPG = 8, NE = 32, DEXP = 512, PLE_DIM = 256;
constexpr float EPS = 1e-6f;

__global__ void __launch_bounds__(256) rmsnorm_k(const float* x, const float* __restrict__ g, float* y) {
    __shared__ float red[4];
    const int row = blockIdx.x, t = threadIdx.x;
    const float4 v = ((const float4*)(x + (size_t)row * D_MODEL))[t];
    float s = v.x * v.x + v.y * v.y + v.z * v.z + v.w * v.w;
    for (int o = 32; o; o >>= 1) s += __shfl_xor(s, o);
    if ((t & 63) == 0) red[t >> 6] = s;
    __syncthreads();
    const float tot = red[0] + red[1] + red[2] + red[3];
    const float r = rsqrtf(tot * (1.f / D_MODEL) + EPS);
    const float4 gg = ((const float4*)g)[t];
    float4 o; o.x = v.x * r * gg.x; o.y = v.y * r * gg.y; o.z = v.z * r * gg.z; o.w = v.w * r * gg.w;
    ((float4*)(y + (size_t)row * D_MODEL))[t] = o;
}

__global__ void __launch_bounds__(256) sgemm_k(const float* __restrict__ A, int lda, const float* __restrict__ B, int ldb, float* __restrict__ C, int ldc,
                                               int M, int N, int K, const float* __restrict__ colscale, const float* __restrict__ R, int ldr,
                                               const int* __restrict__ cnt, const int* __restrict__ off, const int* __restrict__ list, int listStride, size_t strideB) {
    __shared__ float As[16][64 + 4];
    __shared__ float Bs[16][64 + 4];
    const int e = blockIdx.z;
    int Mloc = M, cbase = 0;
    if (cnt) { Mloc = cnt[e]; cbase = off[e]; B += (size_t)e * strideB; }
    const int m0 = blockIdx.y * 64, n0 = blockIdx.x * 64;
    if (m0 >= Mloc) return;
    const int t = threadIdx.x, tx = t & 15, ty = t >> 4;
    const int ar = t >> 2, ak = (t & 3) * 4;
    int arow = -1;
    if (m0 + ar < Mloc) arow = list ? list[(size_t)e * listStride + m0 + ar] : (m0 + ar);
    const int bk = t >> 4, bn = (t & 15) * 4;
    float acc[4][4] = {};
    for (int k0 = 0; k0 < K; k0 += 16) {
        float4 av = make_float4(0.f, 0.f, 0.f, 0.f);
        if (arow >= 0) av = *(const float4*)(A + (size_t)arow * lda + k0 + ak);
        As[ak + 0][ar] = av.x; As[ak + 1][ar] = av.y; As[ak + 2][ar] = av.z; As[ak + 3][ar] = av.w;
        float bv[4];
#pragma unroll
        for (int j = 0; j < 4; ++j) bv[j] = (n0 + bn + j < N) ? B[(size_t)(k0 + bk) * ldb + n0 + bn + j] : 0.f;
#pragma unroll
        for (int j = 0; j < 4; ++j) Bs[bk][bn + j] = bv[j];
        __syncthreads();
#pragma unroll
        for (int kk = 0; kk < 16; ++kk) {
            float a[4], b[4];
#pragma unroll
            for (int i = 0; i < 4; ++i) a[i] = As[kk][ty * 4 + i];
#pragma unroll
            for (int j = 0; j < 4; ++j) b[j] = Bs[kk][tx * 4 + j];
#pragma unroll
            for (int i = 0; i < 4; ++i)
#pragma unroll
                for (int j = 0; j < 4; ++j) acc[i][j] = fmaf(a[i], b[j], acc[i][j]);
        }
        __syncthreads();
    }
#pragma unroll
    for (int i = 0; i < 4; ++i) {
        const int r = m0 + ty * 4 + i;
        if (r >= Mloc) continue;
        const size_t crow = (size_t)(cbase + r);
#pragma unroll
        for (int j = 0; j < 4; ++j) {
            const int n = n0 + tx * 4 + j;
            if (n >= N) continue;
            float v = acc[i][j];
            if (colscale) v *= colscale[n];
            if (R) v += R[crow * ldr + n];
            C[crow * ldc + n] = v;
        }
    }
}

__global__ void fgate_cumsum_k(const float* __restrict__ z, const float* __restrict__ b_f, float* __restrict__ c) {
    const int i = blockIdx.x * blockDim.x + threadIdx.x;
    if (i >= BATCH * NH) return;
    const int b = i / NH, h = i % NH;
    float s = 0.f;
    for (int t = 0; t < SEQ; ++t) {
        const float xl = z[(size_t)(b * SEQ + t) * IN_DIM + 2048 + h] + b_f[h];
        const float lf = fminf(xl, 0.f) - log1pf(expf(-fabsf(xl)));
        s += lf;
        c[(size_t)i * SEQ + t] = s;
    }
}

__global__ void pool_diff_k(const float* __restrict__ z, float* __restrict__ d) {
    const int idx = blockIdx.x * blockDim.x + threadIdx.x;
    if (idx >= NTOK * POOL_DIM) return;
    const int n = idx / POOL_DIM, ch = idx % POOL_DIM, s = n % SEQ;
    const int gi = ch / PGD, w = 2 << gi;
    const int cntw = (s + 1 < w) ? s + 1 : w;
    float sum = 0.f;
    for (int j = 0; j < cntw; ++j) sum += z[(size_t)(n - j) * IN_DIM + ch];
    d[idx] = sum / (float)cntw - z[(size_t)n * IN_DIM + ch];
}

__global__ void __launch_bounds__(256) fox_attn_k(const float* __restrict__ z, const float* __restrict__ c, float* __restrict__ mix) {
    __shared__ float P[4][SEQ];
    __shared__ float Q[4][HEAD_DIM];
    const int wv = threadIdx.x >> 6, lane = threadIdx.x & 63;
    const int row = blockIdx.x * 4 + wv;
    const int t = row % SEQ, bh = row / SEQ, h = bh % NH, b = bh / NH;
    const float* zb = z + (size_t)b * SEQ * IN_DIM;
    Q[wv][lane] = zb[(size_t)t * IN_DIM + 512 + h * 64 + lane] * 0.125f;
    __syncthreads();
    const float* cc = c + (size_t)bh * SEQ;
    const float ct = cc[t];
    float mx = -INFINITY;
    for (int s = lane; s <= t; s += 64) {
        const float* kr = zb + (size_t)s * IN_DIM + 1024 + h * 64;
        float acc = 0.f;
#pragma unroll 16
        for (int dd = 0; dd < 64; ++dd) acc = fmaf(Q[wv][dd], kr[dd], acc);
        acc += ct - cc[s];
        P[wv][s] = acc;
        mx = fmaxf(mx, acc);
    }
    for (int o = 32; o; o >>= 1) mx = fmaxf(mx, __shfl_xor(mx, o));
    float sum = 0.f;
    for (int s = lane; s <= t; s += 64) { const float pe = expf(P[wv][s] - mx); P[wv][s] = pe; sum += pe; }
    for (int o = 32; o; o >>= 1) sum += __shfl_xor(sum, o);
    __syncthreads();
    float o = 0.f;
    for (int s = 0; s <= t; ++s) o = fmaf(P[wv][s], zb[(size_t)s * IN_DIM + 1536 + h * 64 + lane], o);
    mix[(size_t)(b * SEQ + t) * D_MODEL + 512 + h * 64 + lane] = o / sum;
}

__global__ void router_select_k(const float* __restrict__ lg, const float* __restrict__ le, const float* __restrict__ b_grp, const float* __restrict__ b_rt,
                                int* __restrict__ cnt, int* __restrict__ list, float* __restrict__ wl, int* __restrict__ tokpair) {
    const int n = blockIdx.x * blockDim.x + threadIdx.x;
    if (n >= NTOK) return;
    float gl[NG]; float gm = -INFINITY; int gi = 0;
    for (int j = 0; j < NG; ++j) { gl[j] = lg[n * NG + j] + b_grp[j]; if (gl[j] > gm) { gm = gl[j]; gi = j; } }
    float gs = 0.f;
    for (int j = 0; j < NG; ++j) gs += expf(gl[j] - gm);
    const float gw = 1.f / gs;
    float sel[EPG];
    for (int j = 0; j < EPG; ++j) sel[j] = le[n * NE + gi * EPG + j] + b_rt[gi * EPG + j];
    int i1 = 0; float v1 = sel[0];
    for (int j = 1; j < EPG; ++j) if (sel[j] > v1) { v1 = sel[j]; i1 = j; }
    int i2 = -1; float v2 = -INFINITY;
    for (int j = 0; j < EPG; ++j) if (j != i1 && sel[j] > v2) { v2 = sel[j]; i2 = j; }
    const float e2 = expf(v2 - v1);
    const float w1 = gw / (1.f + e2), w2 = gw * e2 / (1.f + e2);
    const int ex1 = gi * EPG + i1, ex2 = gi * EPG + i2;
    const int p1 = atomicAdd(&cnt[ex1], 1), p2 = atomicAdd(&cnt[ex2], 1);
    list[ex1 * NTOK + p1] = n; wl[ex1 * NTOK + p1] = w1;
    list[ex2 * NTOK + p2] = n; wl[ex2 * NTOK + p2] = w2;
    tokpair[n * 4 + 0] = ex1; tokpair[n * 4 + 1] = p1; tokpair[n * 4 + 2] = ex2; tokpair[n * 4 + 3] = p2;
}
__global__ void slotlist_k(const int* __restrict__ cnt, const int* __restrict__ off, int* __restrict__ sl) {
    const int e = blockIdx.y; const int r = blockIdx.x * blockDim.x + threadIdx.x;
    if (r < cnt[e]) sl[e * NTOK + r] = off[e] + r;
}
__global__ void offsets_k(const int* __restrict__ cnt, int* __restrict__ off) {
    if (threadIdx.x == 0 && blockIdx.x == 0) { int s = 0; for (int e = 0; e < NE; ++e) { off[e] = s; s += cnt[e]; } }
}
__global__ void moe_act_k(float* __restrict__ hg, const float* __restrict__ hu, const int* __restrict__ cnt, const int* __restrict__ off, const float* __restrict__ wl) {
    const int e = blockIdx.y;
    const int idx = blockIdx.x * blockDim.x + threadIdx.x;
    const int r = idx / DEXP, f = idx % DEXP;
    if (r >= cnt[e]) return;
    const size_t o = (size_t)(off[e] + r) * DEXP + f;
    const float g = hg[o];
    hg[o] = g / (1.f + expf(-g)) * hu[o] * wl[e * NTOK + r];
}
__global__ void moe_combine_k(float* __restrict__ h, const float* __restrict__ Y, const int* __restrict__ off, const int* __restrict__ tokpair) {
    const int idx = blockIdx.x * blockDim.x + threadIdx.x;
    if (idx >= NTOK * D_MODEL) return;
    const int n = idx / D_MODEL, col = idx % D_MODEL;
    const int s0 = off[tokpair[n * 4 + 0]] + tokpair[n * 4 + 1], s1 = off[tokpair[n * 4 + 2]] + tokpair[n * 4 + 3];
    h[idx] = h[idx] + (Y[(size_t)s0 * D_MODEL + col] + Y[(size_t)s1 * D_MODEL + col]);
}
__global__ void ple_combine_k(float* __restrict__ h, const float* __restrict__ G, const float* __restrict__ Pj) {
    const int idx = blockIdx.x * blockDim.x + threadIdx.x;
    if (idx >= NTOK * D_MODEL) return;
    h[idx] = h[idx] + Pj[idx] / (1.f + expf(-G[idx]));
}

static inline void sgemm(hipStream_t st, const float* A, int lda, const float* B, int ldb, float* C, int ldc, int M, int N, int K,
                         const float* colscale = nullptr, const float* R = nullptr, int ldr = 0,
                         const int* cnt = nullptr, const int* off = nullptr, const int* list = nullptr, int listStride = 0, size_t strideB = 0, int nz = 1) {
    dim3 grid((N + 63) / 64, (M + 63) / 64, nz);
    hipLaunchKernelGGL(sgemm_k, grid, dim3(256), 0, st, A, lda, B, ldb, C, ldc, M, N, K, colscale, R, ldr, cnt, off, list, listStride, strideB);
}

extern "C" void kernel_launch(void* const* d_in, const int* in_sizes, int n_in, void* d_out, int out_size, void* d_ws, size_t ws_size, hipStream_t stream) {
    const float* x = (const float*)d_in[0];      const float* p = (const float*)d_in[1];
    const float* g_mix = (const float*)d_in[2];  const float* w_in = (const float*)d_in[3];
    const float* b_f = (const float*)d_in[4];    const float* w_pool = (const float*)d_in[5];
    const float* s_pool = (const float*)d_in[6]; const float* w_out = (const float*)d_in[7];
    const float* g_ffn = (const float*)d_in[8];  const float* w_grp = (const float*)d_in[9];
    const float* b_grp = (const float*)d_in[10]; const float* w_rt = (const float*)d_in[11];
    const float* b_rt = (const float*)d_in[12];  const float* w_e_gate = (const float*)d_in[13];
    const float* w_e_up = (const float*)d_in[14]; const float* w_e_down = (const float*)d_in[15];
    const float* g_ple = (const float*)d_in[16]; const float* w_ple_gate = (const float*)d_in[17];
    const float* w_ple_proj = (const float*)d_in[18]; const float* g_final = (const float*)d_in[19];
    float* out = (float*)d_out;
    constexpr size_t MiB = 1u << 20;
    unsigned char* ws = (unsigned char*)d_ws;
    if (ws_size < 240 * MiB || n_in != 20) { fprintf(stderr, "kernel_launch: ws %zu too small or n_in %d\n", ws_size, n_in); return; }
    float* Z = (float*)ws;
    float* Z0 = (float*)ws;
    float* Z1 = (float*)(ws + 64 * MiB);
    float* A = (float*)(ws + 136 * MiB);
    float* Dd = (float*)(ws + 200 * MiB);
    unsigned char* misc = ws + 232 * MiB;
    float* cc = (float*)misc;
    int* cnt = (int*)(misc + 1 * MiB);
    int* off = cnt + 64;
    float* lg = (float*)(misc + 1 * MiB + 4096);
    float* le = lg + NTOK * NG;
    int* tokpair = (int*)(le + NTOK * NE);
    int* list = (int*)(misc + 4 * MiB);
    float* wl = (float*)(misc + 6 * MiB);

    hipMemsetAsync(cnt, 0, 512, stream);
    hipLaunchKernelGGL(rmsnorm_k, dim3(NTOK), dim3(256), 0, stream, x, g_mix, A);
    sgemm(stream, A, D_MODEL, w_in, IN_DIM, Z, IN_DIM, NTOK, IN_DIM, D_MODEL);
    hipLaunchKernelGGL(fgate_cumsum_k, dim3(1), dim3(64), 0, stream, Z, b_f, cc);
    hipLaunchKernelGGL(pool_diff_k, dim3(NTOK * POOL_DIM / 256), dim3(256), 0, stream, Z, Dd);
    for (int g = 0; g < NG; ++g)
        sgemm(stream, Dd + g * PGD, POOL_DIM, w_pool + (size_t)g * PGD * PGD, PGD, A + g * PGD, D_MODEL, NTOK, PGD, PGD, s_pool + g * PGD);
    hipLaunchKernelGGL(fox_attn_k, dim3(BATCH * NH * SEQ / 4), dim3(256), 0, stream, Z, cc, A);
    sgemm(stream, A, D_MODEL, w_out, D_MODEL, out, D_MODEL, NTOK, D_MODEL, D_MODEL, nullptr, x, D_MODEL);
    hipLaunchKernelGGL(rmsnorm_k, dim3(NTOK), dim3(256), 0, stream, out, g_ffn, A);
    sgemm(stream, A, D_MODEL, w_grp, NG, lg, NG, NTOK, NG, D_MODEL);
    sgemm(stream, A, D_MODEL, w_rt, NE, le, NE, NTOK, NE, D_MODEL);
    hipLaunchKernelGGL(router_select_k, dim3(NTOK / 256), dim3(256), 0, stream, lg, le, b_grp, b_rt, cnt, list, wl, tokpair);
    hipLaunchKernelGGL(offsets_k, dim3(1), dim3(64), 0, stream, cnt, off);
    float* Hg = Z0; float* Hu = Z1; float* Y = Z1;
    sgemm(stream, A, D_MODEL, w_e_gate, DEXP, Hg, DEXP, NTOK, DEXP, D_MODEL, nullptr, nullptr, 0, cnt, off, list, NTOK, (size_t)D_MODEL * DEXP, NE);
    sgemm(stream, A, D_MODEL, w_e_up, DEXP, Hu, DEXP, NTOK, DEXP, D_MODEL, nullptr, nullptr, 0, cnt, off, list, NTOK, (size_t)D_MODEL * DEXP, NE);
    hipLaunchKernelGGL(moe_act_k, dim3(NTOK * DEXP / 256, NE), dim3(256), 0, stream, Hg, Hu, cnt, off, wl);
    int* slotlist = (int*)Dd;
    hipLaunchKernelGGL(slotlist_k, dim3(NTOK / 256, NE), dim3(256), 0, stream, cnt, off, slotlist);
    sgemm(stream, Hg, DEXP, w_e_down, D_MODEL, Y, D_MODEL, NTOK, D_MODEL, DEXP, nullptr, nullptr, 0, cnt, off, slotlist, NTOK, (size_t)DEXP * D_MODEL, NE);
    hipLaunchKernelGGL(moe_combine_k, dim3(NTOK * D_MODEL / 256), dim3(256), 0, stream, out, Y, off, tokpair);
    hipLaunchKernelGGL(rmsnorm_k, dim3(NTOK), dim3(256), 0, stream, out, g_ple, Z0);
    float* G = Z1; float* Pj = Z1 + (size_t)NTOK * D_MODEL;
    sgemm(stream, Z0, D_MODEL, w_ple_gate, D_MODEL, G, D_MODEL, NTOK, D_MODEL, D_MODEL);
    sgemm(stream, p, PLE_DIM, w_ple_proj, D_MODEL, Pj, D_MODEL, NTOK, D_MODEL, PLE_DIM);
    hipLaunchKernelGGL(ple_combine_k, dim3(NTOK * D_MODEL / 256), dim3(256), 0, stream, out, G, Pj);
    hipLaunchKernelGGL(rmsnorm_k, dim3(NTOK), dim3(256), 0, stream, out, g_final, out);
}
```

```cpp
#include <hip/hip_runtime.h>
#include <hip/hip_bf16.h>
#include <cstdio>
#include <cstdint>
namespace pg8 {
#define PG8_LAS __attribute__((address_space(3)))
typedef unsigned short bf16_t;
typedef short bf16x8 __attribute__((ext_vector_type(8)));
typedef float f32x4 __attribute__((ext_vector_type(4)));
typedef unsigned u32x4 __attribute__((ext_vector_type(4)));
typedef unsigned u32x2 __attribute__((ext_vector_type(2)));
constexpr int BM = 256, BK = 64, HALF = 128, HTB = HALF * BK * 2  , STAGE_BYTES = 8 * HTB, NXCD = 8, WGM = 8;

__host__ __device__ __forceinline__ int lds_byte(int r, int c) { const int st = (r >> 4) * 2 + (c >> 5), rr = r & 15, cc = c & 31, ob = rr * 64 + cc * 2; return st * 1024 + (ob ^ (((ob >> 9) & 1) << 5)); }
__host__ __device__ __forceinline__ void stage_rc(int b, int& R, int& C) { const int st = b / 1024, sb = b % 1024, swz = sb ^ (((sb >> 9) & 1) << 5); R = (st >> 1) * 16 + swz / 64; C = (st & 1) * 32 + (swz % 64) / 2; }
__host__ __device__ __forceinline__ int perm32(int rho) { const int n = rho >> 4, i = rho & 15; return 8 * (i >> 2) + 4 * n + (i & 3); }

struct Unit { int pm, pn; const char* a; const char* b; int x0, x1, x2, x3; };

__device__ __forceinline__ unsigned cvt_pk_bf16(float lo, float hi) { unsigned r; asm volatile("v_cvt_pk_bf16_f32 %0, %1, %2" : "=v"(r) : "v"(lo), "v"(hi)); return r; }

struct StaticSched {
    const char* A; const char* Bt; size_t tstep; int nM, nN, nwg, G, c;
    __device__ __forceinline__ void init(const void* A_, const void* Bt_, int M, int N, int K, int G_, int c_) { A = (const char*)A_; Bt = (const char*)Bt_; tstep = (size_t)BM * K * 2; nM = M / BM; nN = N / BM; nwg = nM * nN; G = G_; c = c_; }
    __device__ __forceinline__ bool next(int i, Unit& u) const {
        const long L = (long)i * G + c; if (L >= nwg) return false;
        int wgid = (int)L; { const int q = nwg / NXCD, r = nwg % NXCD, xcd = wgid % NXCD, off = wgid / NXCD; wgid = (xcd < r ? xcd * (q + 1) : r * (q + 1) + (xcd - r) * q) + off; }
        const int nig = WGM * nN, gid = wgid / nig, fm = gid * WGM, gsz = (nM - fm) < WGM ? (nM - fm) : WGM;
        u.pm = fm + ((wgid % nig) % gsz); u.pn = (wgid % nig) / gsz; u.a = A + (size_t)u.pm * tstep; u.b = Bt + (size_t)u.pn * tstep; u.x0 = u.x1 = u.x2 = u.x3 = 0; return true;
    }
};

template <class Epi, class Sched, bool GATHER, bool ALIGN_EPI>
__device__ __forceinline__ void gemm_phase(PG8_LAS unsigned char* lds, const int K, const Sched& S, const Epi& E, const PG8_LAS int* gidx) {
    const int tid = threadIdx.x, wid = __builtin_amdgcn_readfirstlane(tid >> 6), lane = tid & 63, wr = wid >> 2, wc = wid & 3, fr = lane & 15, fq = lane >> 4;
    const int nt = K / BK;
    unsigned voffB[2], vAc0[2], vAc1[2], vAn0[2], vAn1[2]; int Rr[2], Cc[2];
#pragma unroll
    for (int i = 0; i < 2; ++i) { int R, C; stage_rc(tid * 16 + i * 8192, R, C); const int Rb = Epi::PERM ? ((R & ~31) + perm32(R & 31)) : R; Rr[i] = R; Cc[i] = C; voffB[i] = (unsigned)(Rb * K + C) * 2u; }
#define PG8_SETA(v0, v1, ui_) do { _Pragma("unroll") for (int _i = 0; _i < 2; ++_i) { \
        const int r0_ = GATHER ? gidx[(ui_) * 256 + Rr[_i]] : Rr[_i]; const int r1_ = GATHER ? gidx[(ui_) * 256 + HALF + Rr[_i]] : (HALF + Rr[_i]); \
        v0[_i] = (unsigned)(r0_ * K + Cc[_i]) * 2u; v1[_i] = (unsigned)(r1_ * K + Cc[_i]) * 2u; } } while (0)
    const size_t kstep = (size_t)(BK * 2);
    const size_t hstep = (size_t)HALF * K * 2;
    const unsigned ldsw = (unsigned)wid * 1024u;
    const int aoff = lds_byte(wr * 64 + fr, fq * 8), boff = lds_byte(wc * 32 + fr, fq * 8);
#define PG8_SA(b, h) (((b) * 2 + (h)) * HTB)
#define PG8_SB(b, h) ((4 + (b) * 2 + (h)) * HTB)
#define PG8_STAGE(bufoff, gbase, voff) do { _Pragma("unroll") for (int _i = 0; _i < 2; ++_i) \
        __builtin_amdgcn_global_load_lds((const unsigned*)((const char*)(gbase) + (voff)[_i]), (PG8_LAS unsigned*)(lds + (bufoff) + ldsw + _i * 8192), 16, 0, 0); } while (0)
#define PG8_LDA(dst, b, h) do { _Pragma("unroll") for (int m = 0; m < 4; ++m) _Pragma("unroll") for (int k = 0; k < 2; ++k) dst[m][k] = *(const PG8_LAS bf16x8*)(lds + PG8_SA(b, h) + aoff + m * 2048 + k * 1024); } while (0)
#define PG8_LDB(dst, b, h) do { _Pragma("unroll") for (int n = 0; n < 2; ++n) _Pragma("unroll") for (int k = 0; k < 2; ++k) dst[n][k] = *(const PG8_LAS bf16x8*)(lds + PG8_SB(b, h) + boff + n * 2048 + k * 1024); } while (0)
#define PG8_MMA(ai, bj, At, Bt) do { __builtin_amdgcn_s_setprio(1); _Pragma("unroll") for (int m = 0; m < 4; ++m) _Pragma("unroll") for (int n = 0; n < 2; ++n) _Pragma("unroll") for (int k = 0; k < 2; ++k) \
        acc[ai][bj][m][n] = __builtin_amdgcn_mfma_f32_16x16x32_bf16(Bt[n][k], At[m][k], acc[ai][bj][m][n], 0, 0, 0); __builtin_amdgcn_s_setprio(0); } while (0)
#define PG8_WAIT_V(n) asm volatile("s_waitcnt vmcnt(" #n ")" ::: "memory")
#define PG8_WAIT_L(n) asm volatile("s_waitcnt lgkmcnt(" #n ")" ::: "memory")
#define PG8_BAR __builtin_amdgcn_s_barrier()
#define PG8_SCHED __builtin_amdgcn_sched_barrier(0)
    Unit cur, nxt; int ui = 0;
    if (!S.next(0, cur)) return;
    f32x4 acc[2][2][4][2];
#pragma unroll
    for (int a = 0; a < 2; ++a)
#pragma unroll
        for (int b = 0; b < 2; ++b)
#pragma unroll
            for (int m = 0; m < 4; ++m)
#pragma unroll
                for (int n = 0; n < 2; ++n) acc[a][b][m][n] = (f32x4){0.f, 0.f, 0.f, 0.f};
    bf16x8 At[4][2], B0[2][2], B1[2][2];
    const char* cA = cur.a; const char* cB = cur.b;
    PG8_SETA(vAc0, vAc1, 0);
    PG8_STAGE(PG8_SB(0, 0), cB, voffB); PG8_STAGE(PG8_SB(0, 1), cB + hstep, voffB); PG8_STAGE(PG8_SA(0, 0), cA, vAc0); PG8_STAGE(PG8_SA(0, 1), cA, vAc1);
    if (wr == 1) PG8_BAR;
    PG8_WAIT_V(2); PG8_BAR;
    PG8_STAGE(PG8_SB(1, 0), cB + kstep, voffB); PG8_STAGE(PG8_SA(1, 0), cA + kstep, vAc0); PG8_STAGE(PG8_SB(1, 1), cB + hstep + kstep, voffB);
    PG8_WAIT_V(6); PG8_BAR;
    for (;;) {
        const bool has_next = S.next(ui + 1, nxt);
        const char* nA = has_next ? nxt.a : cA; const char* nB = has_next ? nxt.b : cB;
        if (has_next) { PG8_SETA(vAn0, vAn1, ui + 1); } else { vAn0[0] = vAc0[0]; vAn0[1] = vAc0[1]; vAn1[0] = vAc1[0]; vAn1[1] = vAc1[1]; }
#pragma unroll 1
        for (int t = 0; t < nt; t += 2) {
            const bool last = (t == nt - 2);
            const char* a1 = cA + (size_t)(t + 1) * kstep;
            const char* a2 = last ? nA : cA + (size_t)(t + 2) * kstep; const char* b2 = last ? nB : cB + (size_t)(t + 2) * kstep;
            const char* a3 = a2 + kstep; const char* b3 = b2 + kstep;
            unsigned v20[2], v21[2];
            v20[0] = last ? vAn0[0] : vAc0[0]; v20[1] = last ? vAn0[1] : vAc0[1]; v21[0] = last ? vAn1[0] : vAc1[0]; v21[1] = last ? vAn1[1] : vAc1[1];
            PG8_LDB(B0, 0, 0); PG8_LDB(B1, 0, 1); PG8_SCHED; PG8_LDA(At, 0, 0); PG8_STAGE(PG8_SA(1, 1), a1, vAc1);
            PG8_WAIT_V(8); PG8_WAIT_L(0); PG8_BAR; PG8_MMA(0, 0, At, B0); PG8_MMA(0, 1, At, B1); PG8_BAR; PG8_SCHED;
            PG8_LDA(At, 0, 1); PG8_STAGE(PG8_SB(0, 0), b2, voffB); PG8_STAGE(PG8_SB(0, 1), b2 + hstep, voffB); PG8_STAGE(PG8_SA(0, 0), a2, v20);
            PG8_WAIT_V(8); PG8_WAIT_L(0); PG8_BAR; PG8_MMA(1, 0, At, B0); PG8_MMA(1, 1, At, B1); PG8_BAR; PG8_SCHED;
            PG8_LDB(B0, 1, 0); PG8_LDB(B1, 1, 1); PG8_SCHED; PG8_LDA(At, 1, 0); PG8_STAGE(PG8_SA(0, 1), a2, v21);
            PG8_WAIT_V(8); PG8_WAIT_L(0); PG8_BAR; PG8_MMA(0, 0, At, B0); PG8_MMA(0, 1, At, B1); PG8_BAR; PG8_SCHED;
            PG8_LDA(At, 1, 1); PG8_STAGE(PG8_SB(1, 0), b3, voffB); PG8_STAGE(PG8_SB(1, 1), b3 + hstep, voffB); PG8_STAGE(PG8_SA(1, 0), a3, v20);
            PG8_WAIT_V(8); PG8_WAIT_L(0); PG8_BAR; PG8_MMA(1, 0, At, B0); PG8_MMA(1, 1, At, B1); PG8_BAR; PG8_SCHED;
        }
        if constexpr (ALIGN_EPI) { if (wr == 0) PG8_BAR; }
        E(acc, cur, wr, wc, fr, fq);
        if (!has_next) break;
#pragma unroll
        for (int a = 0; a < 2; ++a)
#pragma unroll
            for (int b = 0; b < 2; ++b)
#pragma unroll
                for (int m = 0; m < 4; ++m)
#pragma unroll
                    for (int n = 0; n < 2; ++n) acc[a][b][m][n] = (f32x4){0.f, 0.f, 0.f, 0.f};
        cur = nxt; cA = nA; cB = nB; ++ui;
        vAc0[0] = vAn0[0]; vAc0[1] = vAn0[1]; vAc1[0] = vAn1[0]; vAc1[1] = vAn1[1];
        if constexpr (ALIGN_EPI) { if (wr == 1) PG8_BAR; }
    }
    PG8_WAIT_V(0);
    if constexpr (!ALIGN_EPI) { if (wr == 0) PG8_BAR; }
    PG8_BAR;
#undef PG8_SETA
#undef PG8_SA
#undef PG8_SB
#undef PG8_STAGE
#undef PG8_LDA
#undef PG8_LDB
#undef PG8_MMA
#undef PG8_WAIT_V
#undef PG8_WAIT_L
#undef PG8_BAR
#undef PG8_SCHED
}
}
namespace fox {
using bf16 = __hip_bfloat16;
using bf16x8 = __attribute__((ext_vector_type(8))) short;
using s16x4 = __attribute__((ext_vector_type(4))) short;
using f32x16 = __attribute__((ext_vector_type(16))) float;
using u32x4 = __attribute__((ext_vector_type(4))) unsigned;
typedef float f32x4v __attribute__((ext_vector_type(4)));
constexpr int SEQ = 2048, D = 64, PITCH = 512, OPITCH = 1024, NHEAD = 8;
constexpr int NW = 8, QBLK = 32, QB = QBLK * NW, KVBLK = 64, NQB = SEQ / QB;
constexpr int SLOTB = 8192, LDS_K = 0, LDS_V = 2 * SLOTB, LDS_C = 4 * SLOTB, LDS_WS = LDS_C + SEQ * 4, LDS_OST = LDS_WS + NW * 64 * 4, LDS_BYTES = LDS_OST + NW * 4096;
constexpr float C2 = 0.125f * 1.4426950408889634f;
__device__ __forceinline__ int crow(int r, int hi) { return (r & 3) + 8 * (r >> 2) + 4 * hi; }
#define FOX_SBAR() __builtin_amdgcn_sched_barrier(0)
__device__ __forceinline__ void cmask(f32x16& p0, f32x16& p1, int jb, int qrel, int hi) {
    const float NEG = -INFINITY; int kb = 64 * jb + 4 * hi;
#pragma unroll
    for (int r = 0; r < 16; ++r) { int kv = kb + (r & 3) + 8 * (r >> 2); if (kv > qrel) p0[r] = NEG; if (kv + 32 > qrel) p1[r] = NEG; }
}
__device__ __forceinline__ void glds16(const void* gsrc, unsigned lds_dst) { unsigned keep;
    asm volatile("s_mov_b32 %0, m0\n\ts_mov_b32 m0, %2\n\ts_nop 0\n\tglobal_load_lds_dwordx4 %1, off\n\ts_mov_b32 m0, %0" : "=&s"(keep) : "v"(gsrc), "s"(lds_dst) : "memory"); }
typedef float f32x2_t __attribute__((ext_vector_type(2))); typedef __bf16 bf16x2_t __attribute__((ext_vector_type(2)));
__device__ __forceinline__ unsigned cvtpk_s(float lo, float hi) { f32x2_t v = {lo, hi}; bf16x2_t b = __builtin_convertvector(v, bf16x2_t); return __builtin_bit_cast(unsigned, b); }
typedef __attribute__((address_space(3))) const char* lds_cptr;
__device__ __forceinline__ float rowmax(const f32x16& p0, const f32x16& p1) {
    float a = fmaxf(p0[0], p1[0]);
#pragma unroll
    for (int r = 1; r < 16; ++r) a = fmaxf(a, fmaxf(p0[r], p1[r]));
    return fmaxf(a, __shfl_xor(a, 32));
}
__device__ __forceinline__ void pv(f32x16* o, int vb, bf16x8 pa0, bf16x8 pa1, bf16x8 pa2, bf16x8 pa3) {
#pragma unroll
    for (int d0 = 0; d0 < 2; ++d0) { s16x4 lo[4], hi[4];
#pragma unroll
        for (int ks = 0; ks < 4; ++ks) {
            asm volatile("ds_read_b64_tr_b16 %0,%1 offset:%c2" : "=&v"(lo[ks]) : "v"(vb), "i"(d0 * 4096 + ks * 1024) : "memory");
            asm volatile("ds_read_b64_tr_b16 %0,%1 offset:%c2" : "=&v"(hi[ks]) : "v"(vb), "i"(d0 * 4096 + ks * 1024 + 512) : "memory"); }
        asm volatile("s_waitcnt lgkmcnt(0)" ::: "memory"); FOX_SBAR();
#define FOX_PK(k) (bf16x8){lo[k][0], lo[k][1], lo[k][2], lo[k][3], hi[k][0], hi[k][1], hi[k][2], hi[k][3]}
        o[d0] = __builtin_amdgcn_mfma_f32_32x32x16_bf16(pa0, FOX_PK(0), o[d0], 0, 0, 0);
        o[d0] = __builtin_amdgcn_mfma_f32_32x32x16_bf16(pa1, FOX_PK(1), o[d0], 0, 0, 0);
        o[d0] = __builtin_amdgcn_mfma_f32_32x32x16_bf16(pa2, FOX_PK(2), o[d0], 0, 0, 0);
        o[d0] = __builtin_amdgcn_mfma_f32_32x32x16_bf16(pa3, FOX_PK(3), o[d0], 0, 0, 0);
#undef FOX_PK
    }
}
#define FOX_WAIT_BAR(N) asm volatile("s_waitcnt vmcnt(" #N ") lgkmcnt(0)\n\ts_barrier" ::: "memory")

__device__ __forceinline__ void attn_unit(int b, int h, int qb, const bf16* Q, const bf16* __restrict__ K, const bf16* __restrict__ V, const float* __restrict__ c2g, bf16* O, int ocol0, char* shm) {
    const int tid = threadIdx.x, lane = tid & 63, r32 = lane & 31, hi = lane >> 5; const int wid = __builtin_amdgcn_readfirstlane(tid >> 6);
    const long rowbase = (long)b * SEQ; const int q0 = qb * QB;
    const bf16* Qw = Q + (rowbase + q0 + wid * QBLK) * PITCH + h * D;
    const bf16* Kh = K + rowbase * PITCH + h * D, *Vh = V + rowbase * PITCH + h * D;
    const unsigned lds0 = (unsigned)(uintptr_t)shm;
    float* wsf = (float*)(shm + LDS_WS) + wid * 64;
    float* cs = (float*)(shm + LDS_C);
    const bf16* ksrc = Kh + (long)lane * PITCH + wid * 8;
    const bf16* vsrc = Vh + (long)(16 * (wid & 3) + (lane >> 2)) * PITCH + (wid >> 2) * 32 + (lane & 3) * 8;
    const unsigned kdst = lds0 + LDS_K + wid * 1024, vdst = lds0 + LDS_V + wid * 1024;
#define FOX_DMA_K(t, slot) glds16(ksrc + (long)(t) * KVBLK * PITCH, (unsigned)__builtin_amdgcn_readfirstlane(kdst + (slot)))
#define FOX_DMA_V(t, slot) glds16(vsrc + (long)(t) * KVBLK * PITCH, (unsigned)__builtin_amdgcn_readfirstlane(vdst + (slot)))
    const int vb0 = (int)(lds0 + LDS_V) + ((lane >> 4) & 1) * 32 + (lane & 3) * 8 + (4 * hi + ((lane & 15) >> 2)) * 64;
    const lds_cptr kp0 = (lds_cptr)shm + LDS_K + hi * 1024 + r32 * 16;
    const int NT = (q0 + QB) / KVBLK;
    FOX_DMA_K(0, 0); FOX_DMA_V(0, 0);
    { const float* cg = c2g + (size_t)(b * NHEAD + h) * SEQ; for (int i = tid; i < q0 + QB; i += NW * 64) cs[i] = cg[i]; }
    bf16x8 qr[4];
#pragma unroll
    for (int d0 = 0; d0 < 4; ++d0) qr[d0] = *reinterpret_cast<const bf16x8*>(&Qw[(long)r32 * PITCH + d0 * 16 + hi * 8]);
    FOX_WAIT_BAR(0);
    const int qrel = wid * QBLK + r32;
    const float cq = cs[q0 + qrel];
    float m_run = -INFINITY, l_reg = 0.f; f32x16 o[2]; o[0] = f32x16{}; o[1] = f32x16{};
    for (int t = 0; t < NT; ++t) {
        const int slot = (t & 1) * SLOTB;
        if (t + 1 < NT) { FOX_DMA_K(t + 1, slot ^ SLOTB); FOX_DMA_V(t + 1, slot ^ SLOTB); FOX_WAIT_BAR(2); } else { FOX_WAIT_BAR(0); }
        f32x16 p0, p1;
#pragma unroll
        for (int g = 0; g < 4; ++g) { const f32x4v ca = *(const f32x4v*)(cs + t * KVBLK + 8 * g + 4 * hi), cb = *(const f32x4v*)(cs + t * KVBLK + 32 + 8 * g + 4 * hi);
#pragma unroll
            for (int j = 0; j < 4; ++j) { p0[4 * g + j] = cq - ca[j]; p1[4 * g + j] = cq - cb[j]; } }
        { const lds_cptr kb = kp0 + slot;
#pragma unroll
          for (int d0 = 0; d0 < 4; ++d0) {
              const bf16x8 b0 = *(const __attribute__((address_space(3))) bf16x8*)(kb + d0 * 2048);
              const bf16x8 b1 = *(const __attribute__((address_space(3))) bf16x8*)(kb + d0 * 2048 + 512);
              p0 = __builtin_amdgcn_mfma_f32_32x32x16_bf16(b0, qr[d0], p0, 0, 0, 0); p1 = __builtin_amdgcn_mfma_f32_32x32x16_bf16(b1, qr[d0], p1, 0, 0, 0); } }
        { const int jb = t - (NT - 4); if (jb >= 0) cmask(p0, p1, jb, qrel, hi); }
        const float rm = rowmax(p0, p1);
        const float m_new = fmaxf(m_run, rm);
        const float alpha = __builtin_amdgcn_exp2f(m_run - m_new);
        m_run = m_new;
        float sacc = 0.f;
#pragma unroll
        for (int r = 0; r < 16; ++r) { p0[r] = __builtin_amdgcn_exp2f(p0[r] - m_new); p1[r] = __builtin_amdgcn_exp2f(p1[r] - m_new); sacc += p0[r] + p1[r]; }
        l_reg = l_reg * alpha + sacc;
        if (hi == 0) wsf[r32] = alpha;
        asm volatile("s_waitcnt lgkmcnt(0)" ::: "memory");
#pragma unroll
        for (int d_ = 0; d_ < 2; ++d_)
#pragma unroll
            for (int r = 0; r < 16; ++r) o[d_][r] *= wsf[crow(r, hi)];
        u32x4 pw0, pw1, pw2, pw3;
#define FOX_PKW(P, B) cvtpk_s(P[B], P[B + 1])
        pw0 = (u32x4){FOX_PKW(p0, 0), FOX_PKW(p0, 2), FOX_PKW(p0, 4), FOX_PKW(p0, 6)}; pw1 = (u32x4){FOX_PKW(p0, 8), FOX_PKW(p0, 10), FOX_PKW(p0, 12), FOX_PKW(p0, 14)};
        pw2 = (u32x4){FOX_PKW(p1, 0), FOX_PKW(p1, 2), FOX_PKW(p1, 4), FOX_PKW(p1, 6)}; pw3 = (u32x4){FOX_PKW(p1, 8), FOX_PKW(p1, 10), FOX_PKW(p1, 12), FOX_PKW(p1, 14)};
#undef FOX_PKW
        FOX_SBAR();
        pv(o, vb0 + slot, __builtin_bit_cast(bf16x8, pw0), __builtin_bit_cast(bf16x8, pw1), __builtin_bit_cast(bf16x8, pw2), __builtin_bit_cast(bf16x8, pw3));
        asm volatile("s_waitcnt lgkmcnt(0)\n\ts_barrier" ::: "memory");
    }
    l_reg += __shfl_xor(l_reg, 32);
    if (hi == 0) wsf[32 + r32] = l_reg; asm volatile("s_waitcnt lgkmcnt(0)" ::: "memory");
    float rli[16];
#pragma unroll
    for (int r = 0; r < 16; ++r) rli[r] = 1.0f / wsf[32 + crow(r, hi)];
    bf16* Ow = O + (rowbase + q0 + wid * QBLK) * OPITCH + ocol0 + h * D;
    { bf16* stg = (bf16*)(shm + LDS_OST) + wid * 2048;
#pragma unroll
      for (int r = 0; r < 16; ++r) { const int orow = crow(r, hi);
#pragma unroll
          for (int d0 = 0; d0 < 2; ++d0) stg[orow * 64 + d0 * 32 + r32] = __float2bfloat16(o[d0][r] * rli[r]); }
      asm volatile("s_waitcnt lgkmcnt(0)" ::: "memory");
#pragma unroll
      for (int i = 0; i < 4; ++i) { const int row = i * 8 + (lane >> 3), ch = lane & 7; const u32x4 v = *(const u32x4*)(stg + row * 64 + ch * 8); *(u32x4*)(Ow + (long)row * OPITCH + ch * 8) = v; } }
    asm volatile("s_waitcnt vmcnt(0) lgkmcnt(0)\n\ts_barrier" ::: "memory");
#undef FOX_DMA_K
#undef FOX_DMA_V
}
#undef FOX_SBAR
#undef FOX_WAIT_BAR
}
constexpr int NWAVES = 8;
constexpr int M_TOK = 16384, DM = 1024, SEQL = 2048, NBATCH = 8, NHD = 8, HDIM = 64, ADIM = 512, PDIM = 512, PGD_ = 128, INDIM = 2056;
constexpr int NEXP = 32, FEXP = 512, PLED = 256;
constexpr float RMS_EPS = 1e-6f, LOG2E = 1.4426950408889634f;

constexpr size_t MiB = 1u << 20, KiB = 1u << 10;
constexpr size_t WS_CTL = 0, CTL_ZERO_BYTES = 256 * KiB;
constexpr size_t WS_WIN = 1 * MiB;
constexpr size_t WS_WOUT = 5 * MiB;
constexpr size_t WS_WPG = 7 * MiB;
constexpr size_t WS_WPP = 9 * MiB;
constexpr size_t WS_WPOOL = 9 * MiB + 512 * KiB;
constexpr size_t WS_WRT = 9 * MiB + 768 * KiB;
constexpr size_t WS_WF = 10 * MiB;
constexpr size_t WS_C2 = 10 * MiB + 512 * KiB;
constexpr size_t WS_LOGF = 11 * MiB;
constexpr size_t WS_TOKPAIR = 11 * MiB + 512 * KiB;
constexpr size_t WS_LIST = 12 * MiB;
constexpr size_t WS_WL = 14 * MiB;
constexpr size_t WS_WGU = 16 * MiB;
constexpr size_t WS_WDN = 80 * MiB;
constexpr size_t WS_XN = 112 * MiB;
constexpr size_t WS_U = 144 * MiB, WS_Q = 160 * MiB, WS_K = 176 * MiB, WS_V = 192 * MiB;
constexpr size_t WS_ACT = 144 * MiB;
constexpr size_t WS_PROJ = 177 * MiB;
constexpr size_t WS_PBF = 209 * MiB;
constexpr size_t WS_MIX = 217 * MiB;
constexpr size_t WS_YP = 217 * MiB;
constexpr size_t WS_END = 281 * MiB;
constexpr int CW_TMO = 0, CW_CNT = 2048, CW_BAR = 4096;

constexpr int RING_OFF = 0, RING_BYTES = 131072;
constexpr int LDSCTL_OFF = 147456;
constexpr int LC_MISC = LDSCTL_OFF, LC_CNT = LDSCTL_OFF + 128, LC_TPRE = LDSCTL_OFF + 256, LC_COFF = LDSCTL_OFF + 512, LC_TAB = LDSCTL_OFF + 768,
              LC_HIST = LDSCTL_OFF + 1024, LC_HBASE = LDSCTL_OFF + 1152, LC_PEND = LDSCTL_OFF + 2048, LC_GIDX = LDSCTL_OFF + 4096;
constexpr int LDS_BYTES = LDSCTL_OFF + 8192;

#define GAS __attribute__((address_space(1)))
#define LAS __attribute__((address_space(3)))
typedef unsigned short bf16;
typedef unsigned v4u __attribute__((ext_vector_type(4)));
typedef unsigned v2u __attribute__((ext_vector_type(2)));
typedef float f32x4 __attribute__((ext_vector_type(4)));
typedef short bf16x8 __attribute__((ext_vector_type(8)));
typedef float f32x16 __attribute__((ext_vector_type(16)));
typedef GAS unsigned gu32;
#define RLX_AGENT __ATOMIC_RELAXED, __HIP_MEMORY_SCOPE_AGENT
#define LDS_WAIT() asm volatile("s_waitcnt lgkmcnt(0)" ::: "memory")
#define VM_WAIT() asm volatile("s_waitcnt vmcnt(0)" ::: "memory")
__device__ __forceinline__ unsigned f2bf(float f) { unsigned u = __builtin_bit_cast(unsigned, f); return (u + 0x7fffu + ((u >> 16) & 1u)) >> 16; }
__device__ __forceinline__ unsigned pk2(float lo, float hi) { return f2bf(lo) | (f2bf(hi) << 16); }
__device__ __forceinline__ float bf_lo(unsigned w) { return __builtin_bit_cast(float, w << 16); }
__device__ __forceinline__ float bf_hi(unsigned w) { return __builtin_bit_cast(float, w & 0xffff0000u); }

#define XB_TMO      128
#define XB_XCNT(j)  (256  + 64 * (j))
#define XB_XSUB(j)  (1280 + 64 * (j))
#define XB_XGEN(j)  (2304 + 64 * (j))
#define XB_TOP      3328
#define XB_TOPGEN   3392
#define XCD_BAR_WORDS 3456
#define XB_SPIN_CAP (1u << 18)
__device__ __forceinline__ unsigned xb_ld(unsigned* p)              { return __hip_atomic_load(p, __ATOMIC_RELAXED, __HIP_MEMORY_SCOPE_AGENT); }
__device__ __forceinline__ unsigned xb_add(unsigned* p, unsigned v) { return __hip_atomic_fetch_add(p, v, __ATOMIC_RELAXED, __HIP_MEMORY_SCOPE_AGENT); }
__device__ __forceinline__ unsigned xb_xcc_id() { return (unsigned)__builtin_amdgcn_s_getreg((3 << 11) | 20) & 0xFu; }
#define XB_SPIN(cond, bar) do { unsigned _sp = 0; while (cond) { __builtin_amdgcn_s_sleep(1); \
    if ((++_sp & 255u) == 0u) { if (xb_ld(&(bar)[XB_TMO])) break; if (_sp > XB_SPIN_CAP) { atomicAdd(&(bar)[XB_TMO], 1u); break; } } } } while (0)
struct XcdBarrier { unsigned* bar; unsigned x; volatile LAS unsigned* st; };
__device__ __forceinline__ XcdBarrier xcd_barrier_post(unsigned* bar, volatile LAS unsigned* st) {
    XcdBarrier b; b.bar = bar; b.x = xb_xcc_id(); b.st = st;
    if (threadIdx.x == 0) (void)xb_add(&bar[XB_XCNT(b.x)], 1u);
    return b;
}
__device__ __forceinline__ void xcd_barrier_complete(unsigned* bar, unsigned x, unsigned& nloc, unsigned& nx) {
    const unsigned G = gridDim.x * gridDim.y * gridDim.z;
    unsigned sum, cnt, mine, sp = 0u;
    for (;;) {
        sum = 0u; cnt = 0u; mine = 0u;
#pragma unroll
        for (unsigned j = 0; j < 16; ++j) { const unsigned c = xb_ld(&bar[XB_XCNT(j)]); sum += c; cnt += (c > 0u) ? 1u : 0u; mine = (j == x) ? c : mine; }
        if (sum == G) break;
        __builtin_amdgcn_s_sleep(1);
        if ((++sp & 255u) == 0u) { if (xb_ld(&bar[XB_TMO])) break; if (sp > XB_SPIN_CAP) { atomicAdd(&bar[XB_TMO], 1u); break; } }
    }
    nloc = mine > 0u ? mine : 1u; nx = cnt > 0u ? cnt : 1u;
}
__device__ __forceinline__ void xcd_barrier(const XcdBarrier& b) {
    asm volatile("s_waitcnt vmcnt(0)" ::: "memory");
    __syncthreads();
    if (threadIdx.x == 0) {
        unsigned* bar = b.bar;
        __builtin_amdgcn_s_waitcnt(0);
        unsigned nloc = b.st[0], nx = b.st[1];
        if (nloc == 0u) { xcd_barrier_complete(bar, b.x, nloc, nx); b.st[0] = nloc; b.st[1] = nx; }
        const unsigned old = xb_add(&bar[XB_XSUB(b.x)], 1u);
        const unsigned gen = old / nloc;
        if (old + 1u == (gen + 1u) * nloc) {
            __builtin_amdgcn_fence(__ATOMIC_RELEASE, "agent");
            asm volatile("s_waitcnt vmcnt(0)" ::: "memory");
            const unsigned og = xb_add(&bar[XB_TOP], 1u);
            const unsigned tg = og / nx;
            if (og + 1u == (tg + 1u) * nx) xb_add(&bar[XB_TOPGEN], 1u);
            else XB_SPIN(xb_ld(&bar[XB_TOPGEN]) == tg, bar);
            __builtin_amdgcn_fence(__ATOMIC_ACQUIRE, "agent");
            xb_add(&bar[XB_XGEN(b.x)], 1u);
            asm volatile("s_waitcnt vmcnt(0)" ::: "memory");
        } else {
            XB_SPIN(xb_ld(&bar[XB_XGEN(b.x)]) == gen, bar);
            __builtin_amdgcn_fence(__ATOMIC_ACQUIRE, "agent");
            asm volatile("s_waitcnt vmcnt(0)" ::: "memory");
        }
    }
    __syncthreads();
}

namespace pg8 {
struct EpiSplit4 {
    static constexpr bool PERM = true;
    bf16_t* O; size_t stride; float qscale;
    __device__ __forceinline__ void operator()(const f32x4 (&acc)[2][2][4][2], const Unit& u, int wr, int wc, int fr, int fq) const {
        const int row0 = u.pm * BM + wr * 64 + fr; const int t = u.pn >> 1; bf16_t* base = O + (size_t)t * stride; const float sc = (t == 1) ? qscale : 1.f;
        const int col0 = (u.pn & 1) * BM + wc * 32 + 8 * fq;
#pragma unroll
        for (int ai = 0; ai < 2; ++ai)
#pragma unroll
            for (int m = 0; m < 4; ++m) { bf16_t* rowp = base + (size_t)(row0 + ai * HALF + m * 16) * 512 + col0;
#pragma unroll
                for (int bj = 0; bj < 2; ++bj) { const f32x4 v0 = acc[ai][bj][m][0] * sc, v1 = acc[ai][bj][m][1] * sc;
                    u32x4 w; w.x = cvt_pk_bf16(v0[0], v0[1]); w.y = cvt_pk_bf16(v0[2], v0[3]); w.z = cvt_pk_bf16(v1[0], v1[1]); w.w = cvt_pk_bf16(v1[2], v1[3]);
                    *(u32x4*)(rowp + bj * HALF) = w; } }
    }
};
struct EpiBf16Plain {
    static constexpr bool PERM = true;
    bf16_t* O; int ldc;
    __device__ __forceinline__ void operator()(const f32x4 (&acc)[2][2][4][2], const Unit& u, int wr, int wc, int fr, int fq) const {
        const int row0 = u.pm * BM + wr * 64 + fr, col0 = u.pn * BM + wc * 32 + 8 * fq;
#pragma unroll
        for (int ai = 0; ai < 2; ++ai)
#pragma unroll
            for (int m = 0; m < 4; ++m) { bf16_t* rowp = O + (size_t)(row0 + ai * HALF + m * 16) * ldc + col0;
#pragma unroll
                for (int bj = 0; bj < 2; ++bj) { const f32x4 v0 = acc[ai][bj][m][0], v1 = acc[ai][bj][m][1];
                    u32x4 w; w.x = cvt_pk_bf16(v0[0], v0[1]); w.y = cvt_pk_bf16(v0[2], v0[3]); w.z = cvt_pk_bf16(v1[0], v1[1]); w.w = cvt_pk_bf16(v1[2], v1[3]);
                    *(u32x4*)(rowp + bj * HALF) = w; } }
    }
};
struct EpiResF32 {
    static constexpr bool PERM = false;
    const float* X; float* H;
    __device__ __forceinline__ void operator()(const f32x4 (&acc)[2][2][4][2], const Unit& u, int wr, int wc, int fr, int fq) const {
        const int row0 = u.pm * BM + wr * 64 + fr, col0 = u.pn * BM + wc * 32 + 4 * fq;
#pragma unroll
        for (int ai = 0; ai < 2; ++ai)
#pragma unroll
            for (int m = 0; m < 4; ++m) { const size_t off = (size_t)(row0 + ai * HALF + m * 16) * 1024 + col0;
#pragma unroll
                for (int bj = 0; bj < 2; ++bj)
#pragma unroll
                    for (int n = 0; n < 2; ++n) *(f32x4*)(H + off + bj * HALF + n * 16) = *(const f32x4*)(X + off + bj * HALF + n * 16) + acc[ai][bj][m][n]; }
    }
};
__device__ __forceinline__ float silu_f(float g) { return g * __builtin_amdgcn_rcpf(1.f + __builtin_amdgcn_exp2f(-g * 1.4426950408889634f)); }
__device__ __forceinline__ float sigmoid_f(float g) { return __builtin_amdgcn_rcpf(1.f + __builtin_amdgcn_exp2f(-g * 1.4426950408889634f)); }
struct EpiMoeAct {
    static constexpr bool PERM = true;
    bf16_t* ACT; const float* WL;
    __device__ __forceinline__ void operator()(const f32x4 (&acc)[2][2][4][2], const Unit& u, int wr, int wc, int fr, int fq) const {
        const int col0 = u.pn * HALF + wc * 32 + 8 * fq;
#pragma unroll
        for (int ai = 0; ai < 2; ++ai)
#pragma unroll
            for (int m = 0; m < 4; ++m) { const int r = ai * HALF + wr * 64 + m * 16 + fr;
                if (r < u.x1) { const float w = WL[u.x2 + r]; const f32x4 g0 = acc[ai][0][m][0], g1 = acc[ai][0][m][1], u0 = acc[ai][1][m][0], u1 = acc[ai][1][m][1];
                    u32x4 o; o.x = cvt_pk_bf16(silu_f(g0[0]) * u0[0] * w, silu_f(g0[1]) * u0[1] * w); o.y = cvt_pk_bf16(silu_f(g0[2]) * u0[2] * w, silu_f(g0[3]) * u0[3] * w);
                    o.z = cvt_pk_bf16(silu_f(g1[0]) * u1[0] * w, silu_f(g1[1]) * u1[1] * w); o.w = cvt_pk_bf16(silu_f(g1[2]) * u1[2] * w, silu_f(g1[3]) * u1[3] * w);
                    *(u32x4*)(ACT + (size_t)(u.x0 + r) * 512 + col0) = o; } }
    }
};
struct EpiMoeDown {
    static constexpr bool PERM = true;
    bf16_t* YP;
    __device__ __forceinline__ void operator()(const f32x4 (&acc)[2][2][4][2], const Unit& u, int wr, int wc, int fr, int fq) const {
        const int col0 = u.pn * BM + wc * 32 + 8 * fq;
#pragma unroll
        for (int ai = 0; ai < 2; ++ai)
#pragma unroll
            for (int m = 0; m < 4; ++m) { const int r = ai * HALF + wr * 64 + m * 16 + fr;
                if (r < u.x1) { bf16_t* rowp = YP + (size_t)(u.x0 + r) * 1024 + col0;
#pragma unroll
                    for (int bj = 0; bj < 2; ++bj) { const f32x4 v0 = acc[ai][bj][m][0], v1 = acc[ai][bj][m][1];
                        u32x4 w; w.x = cvt_pk_bf16(v0[0], v0[1]); w.y = cvt_pk_bf16(v0[2], v0[3]); w.z = cvt_pk_bf16(v1[0], v1[1]); w.w = cvt_pk_bf16(v1[2], v1[3]);
                        *(u32x4*)(rowp + bj * HALF) = w; } } }
    }
};
struct EpiPle {
    static constexpr bool PERM = true;
    float* H; const bf16_t* PROJ;
    __device__ __forceinline__ void operator()(const f32x4 (&acc)[2][2][4][2], const Unit& u, int wr, int wc, int fr, int fq) const {
        const int row0 = u.pm * BM + wr * 64 + fr, col0 = u.pn * BM + wc * 32 + 8 * fq;
#pragma unroll
        for (int ai = 0; ai < 2; ++ai)
#pragma unroll
            for (int m = 0; m < 4; ++m) { const size_t off = (size_t)(row0 + ai * HALF + m * 16) * 1024 + col0;
#pragma unroll
                for (int bj = 0; bj < 2; ++bj) { const u32x4 pw = *(const u32x4*)(PROJ + off + bj * HALF);
                    const f32x4 h0 = *(const f32x4*)(H + off + bj * HALF), h1 = *(const f32x4*)(H + off + bj * HALF + 4); const f32x4 a0 = acc[ai][bj][m][0], a1 = acc[ai][bj][m][1];
                    f32x4 o0, o1;
                    o0[0] = h0[0] + sigmoid_f(a0[0]) * __builtin_bit_cast(float, pw.x << 16); o0[1] = h0[1] + sigmoid_f(a0[1]) * __builtin_bit_cast(float, pw.x & 0xffff0000u);
                    o0[2] = h0[2] + sigmoid_f(a0[2]) * __builtin_bit_cast(float, pw.y << 16); o0[3] = h0[3] + sigmoid_f(a0[3]) * __builtin_bit_cast(float, pw.y & 0xffff0000u);
                    o1[0] = h1[0] + sigmoid_f(a1[0]) * __builtin_bit_cast(float, pw.z << 16); o1[1] = h1[1] + sigmoid_f(a1[1]) * __builtin_bit_cast(float, pw.z & 0xffff0000u);
                    o1[2] = h1[2] + sigmoid_f(a1[2]) * __builtin_bit_cast(float, pw.w << 16); o1[3] = h1[3] + sigmoid_f(a1[3]) * __builtin_bit_cast(float, pw.w & 0xffff0000u);
                    *(f32x4*)(H + off + bj * HALF) = o0; *(f32x4*)(H + off + bj * HALF + 4) = o1; }
                asm volatile("" ::: "memory"); }
    }
};
struct MoeSched {
    const PG8_LAS int* tab; const char* A; const char* Bt; size_t estride, tstep; int Kb2; bool gather;
    __device__ __forceinline__ bool next(int i, Unit& u) const {
        if (i >= 4) return false;
        if (__builtin_amdgcn_readfirstlane(tab[i * 8 + 0]) == 0) return false;
        const int e = __builtin_amdgcn_readfirstlane(tab[i * 8 + 1]), mt = __builtin_amdgcn_readfirstlane(tab[i * 8 + 2]), pn = __builtin_amdgcn_readfirstlane(tab[i * 8 + 3]);
        const int rowbase = __builtin_amdgcn_readfirstlane(tab[i * 8 + 4]), nvalid = __builtin_amdgcn_readfirstlane(tab[i * 8 + 5]);
        u.pm = mt; u.pn = pn; u.b = Bt + (size_t)e * estride + (size_t)pn * tstep; u.a = gather ? A : A + (size_t)rowbase * Kb2;
        u.x0 = rowbase; u.x1 = nvalid; u.x2 = e * 16384 + mt * 256; u.x3 = e; return true;
    }
};
}
struct Args { const float* in[20]; float* out; unsigned char* ws; int ph_lo, ph_hi, li, pad; };
constexpr int NPHASE = 10;
#ifndef MK_PHMASK
#define MK_PHMASK 0x3ff
#endif

__device__ __forceinline__ float wave_sum(float v) {
#pragma unroll
    for (int o = 1; o < 64; o <<= 1) v += __shfl_xor(v, o);
    return v;
}
__device__ __forceinline__ void p0_transpose_item(const float* W, int ldw, int K, bf16* WT, int k0, int n0, int drow0, LAS float* scr, int lane) {
#pragma unroll 8
    for (int i = 0; i < 32; ++i) { const int kk = 2 * i + (lane >> 5); scr[kk * 33 + (lane & 31)] = W[(size_t)(k0 + kk) * ldw + n0 + (lane & 31)]; }
    LDS_WAIT(); asm volatile("" ::: "memory");
    const int c = lane & 7;
#pragma unroll
    for (int j = 0; j < 4; ++j) { const int n = (lane >> 3) + 8 * j; const LAS float* s = scr + (8 * c) * 33 + n;
        v4u o; o.x = pk2(s[0 * 33], s[1 * 33]); o.y = pk2(s[2 * 33], s[3 * 33]); o.z = pk2(s[4 * 33], s[5 * 33]); o.w = pk2(s[6 * 33], s[7 * 33]);
        *(GAS v4u*)(WT + (size_t)(drow0 + n) * K + k0 + 8 * c) = o; }
    LDS_WAIT(); asm volatile("" ::: "memory");
}

__global__ void __launch_bounds__(NWAVES * 64, 2) mk_fwd(Args args) {
    extern __shared__ __attribute__((aligned(16))) unsigned char lds[];
    LAS unsigned char* L = (LAS unsigned char*)lds;
    const int tid = threadIdx.x, lane = tid & 63, wave = __builtin_amdgcn_readfirstlane(tid >> 6);
    const int G = gridDim.x; const int bx = blockIdx.x; const int vcu = (G % 8 == 0) ? (bx % 8) * (G / 8) + bx / 8 : bx;
    unsigned char* ws = args.ws;
    gu32* ctl = (gu32*)(ws + WS_CTL);
    const float* x = args.in[0]; const float* p_in = args.in[1]; const float* g_mix = args.in[2]; const float* w_in = args.in[3]; const float* b_f = args.in[4];
    const float* w_pool = args.in[5]; const float* s_pool = args.in[6]; const float* w_out = args.in[7]; const float* g_ffn = args.in[8]; const float* w_grp = args.in[9];
    const float* b_grp = args.in[10]; const float* w_rt = args.in[11]; const float* b_rt = args.in[12]; const float* w_e_gate = args.in[13]; const float* w_e_up = args.in[14];
    const float* w_e_down = args.in[15]; const float* g_ple = args.in[16]; const float* w_ple_gate = args.in[17]; const float* w_ple_proj = args.in[18]; const float* g_final = args.in[19];
    float* H = args.out;
    bf16* WIN = (bf16*)(ws + WS_WIN); bf16* WOUT = (bf16*)(ws + WS_WOUT); bf16* WPG = (bf16*)(ws + WS_WPG); bf16* WPP = (bf16*)(ws + WS_WPP); bf16* WPOOL = (bf16*)(ws + WS_WPOOL);
    float* WRT = (float*)(ws + WS_WRT); float* WF = (float*)(ws + WS_WF); float* C2G = (float*)(ws + WS_C2); float* LOGF = (float*)(ws + WS_LOGF);
    int* TOKPAIR = (int*)(ws + WS_TOKPAIR); int* LIST = (int*)(ws + WS_LIST); float* WL = (float*)(ws + WS_WL);
    bf16* WGU = (bf16*)(ws + WS_WGU); bf16* WDN = (bf16*)(ws + WS_WDN); bf16* XN = (bf16*)(ws + WS_XN);
    bf16* UB = (bf16*)(ws + WS_U); bf16* QB_ = (bf16*)(ws + WS_Q); bf16* KB = (bf16*)(ws + WS_K); bf16* VB = (bf16*)(ws + WS_V);
    bf16* ACT = (bf16*)(ws + WS_ACT); bf16* PROJ = (bf16*)(ws + WS_PROJ); bf16* PBF = (bf16*)(ws + WS_PBF); bf16* MIX = (bf16*)(ws + WS_MIX); bf16* YP = (bf16*)(ws + WS_YP);
    unsigned* GCNT = (unsigned*)(ctl + CW_CNT);

    for (int u = tid; u < (LDS_BYTES - LDSCTL_OFF) / 4; u += NWAVES * 64) ((LAS unsigned*)(L + LDSCTL_OFF))[u] = 0u;
    __syncthreads();
    volatile LAS unsigned* MISC = (volatile LAS unsigned*)(L + LC_MISC);
    XcdBarrier bar = xcd_barrier_post((unsigned*)(ctl + CW_BAR) + args.li * XCD_BAR_WORDS, MISC + 8);
    const int lo = args.ph_lo, hi = args.ph_hi;
#define IN(k) (lo <= (k) && (k) < hi)
#define BOTH(k) (IN(k) && IN((k) + 1))
#define GRID_BAR() xcd_barrier(bar)
    const int gw = vcu * NWAVES + wave, NGW = G * NWAVES;

    if (((MK_PHMASK >> 0) & 1) && IN(0)) {
        LAS float* scr = (LAS float*)(L + RING_OFF + wave * 16384);
        constexpr int I_IN = 16 * 64, I_OUT = 16 * 32, I_PG = 16 * 32, I_PP = 4 * 32, I_POOL = 4 * 2 * 4, I_G = 32 * 16 * 16, I_U = I_G, I_D = 32 * 8 * 32;
        constexpr int NITEMS = I_IN + I_OUT + I_PG + I_PP + I_POOL + I_G + I_U + I_D;
        for (int it = gw; it < NITEMS; it += NGW) {
            int r = it;
            if (r < I_IN) { const int kb = r / 64, nb = r % 64; p0_transpose_item(w_in, INDIM, 1024, WIN, 64 * kb, 32 * nb, 32 * nb, scr, lane); continue; } r -= I_IN;
            if (r < I_OUT) { const int kb = r / 32, nb = r % 32; p0_transpose_item(w_out, 1024, 1024, WOUT, 64 * kb, 32 * nb, 32 * nb, scr, lane); continue; } r -= I_OUT;
            if (r < I_PG) { const int kb = r / 32, nb = r % 32; p0_transpose_item(w_ple_gate, 1024, 1024, WPG, 64 * kb, 32 * nb, 32 * nb, scr, lane); continue; } r -= I_PG;
            if (r < I_PP) { const int kb = r / 32, nb = r % 32; p0_transpose_item(w_ple_proj, 1024, 256, WPP, 64 * kb, 32 * nb, 32 * nb, scr, lane); continue; } r -= I_PP;
            if (r < I_POOL) { const int g = r / 8, q = r % 8, kb = q / 4, nb = q % 4; p0_transpose_item(w_pool + (size_t)g * 128 * 128, 128, 128, WPOOL + (size_t)g * 128 * 128, 64 * kb, 32 * nb, 32 * nb, scr, lane); continue; } r -= I_POOL;
            if (r < I_G) { const int e = r / 256, q = r % 256, kb = q / 16, nb = q % 16, n0 = 32 * nb; p0_transpose_item(w_e_gate + (size_t)e * 1024 * 512, 512, 1024, WGU + (size_t)e * 1024 * 1024, 64 * kb, n0, (n0 >> 7) * 256 + (n0 & 127), scr, lane); continue; } r -= I_G;
            if (r < I_U) { const int e = r / 256, q = r % 256, kb = q / 16, nb = q % 16, n0 = 32 * nb; p0_transpose_item(w_e_up + (size_t)e * 1024 * 512, 512, 1024, WGU + (size_t)e * 1024 * 1024, 64 * kb, n0, (n0 >> 7) * 256 + 128 + (n0 & 127), scr, lane); continue; } r -= I_U;
            { const int e = r / 256, q = r % 256, kb = q / 32, nb = q % 32; p0_transpose_item(w_e_down + (size_t)e * 512 * 1024, 1024, 512, WDN + (size_t)e * 1024 * 512, 64 * kb, 32 * nb, 32 * nb, scr, lane); }
        }
        for (int i = gw * 64 + lane; i < 36 * 1024; i += NGW * 64) { const int o = i >> 10, k = i & 1023; WRT[i] = (o < 32) ? w_rt[k * 32 + o] : w_grp[k * 4 + (o - 32)]; }
        __syncthreads();
        LAS float* wf = (LAS float*)(L + RING_OFF);
        for (int i = tid; i < 8 * 1024; i += NWAVES * 64) { const int k = i >> 3, h = i & 7; wf[h * 1024 + k] = w_in[(size_t)k * INDIM + 2048 + h]; }
        __syncthreads();
        f32x4 gm[4];
#pragma unroll
        for (int j = 0; j < 4; ++j) gm[j] = ((const GAS f32x4*)g_mix)[lane + 64 * j];
        const float bfl = b_f[lane & 7];
        for (int m = gw; m < M_TOK; m += NGW) {
            const GAS f32x4* xr = (const GAS f32x4*)(x + (size_t)m * DM) + lane;
            f32x4 v[4]; float s2 = 0.f;
#pragma unroll
            for (int j = 0; j < 4; ++j) { v[j] = xr[64 * j]; s2 += (v[j].x * v[j].x + v[j].y * v[j].y) + (v[j].z * v[j].z + v[j].w * v[j].w); }
            const float rstd = 1.f / sqrtf(wave_sum(s2) * (1.f / DM) + RMS_EPS);
#pragma unroll
            for (int j = 0; j < 4; ++j) v[j] = v[j] * rstd * gm[j];
            GAS unsigned long long* o8 = (GAS unsigned long long*)(XN + (size_t)m * DM) + lane;
#pragma unroll
            for (int j = 0; j < 4; ++j) o8[64 * j] = (unsigned long long)pk2(v[j].x, v[j].y) | ((unsigned long long)pk2(v[j].z, v[j].w) << 32);
            float fl = 0.f;
#pragma unroll
            for (int h = 0; h < 8; ++h) { float a = 0.f;
#pragma unroll
                for (int j = 0; j < 4; ++j) { const f32x4 w = *(const LAS f32x4*)(wf + h * 1024 + 4 * lane + 256 * j); a += (v[j].x * w.x + v[j].y * w.y) + (v[j].z * w.z + v[j].w * w.w); }
                a = wave_sum(a); if ((lane & 7) == h) fl = a; }
            if (lane < 8) { const float xl = fl + bfl; const float lf = fminf(xl, 0.f) - log1pf(__expf(-fabsf(xl)));
                const int b = m / SEQL, s = m % SEQL; LOGF[(size_t)(b * NHD + lane) * SEQL + s] = lf; }
        }
        if (BOTH(0)) GRID_BAR();
    }

    if (((MK_PHMASK >> 1) & 1) && IN(1)) {
        for (int bh = vcu; bh < NBATCH * NHD; bh += G) {
            const f32x4 v = ((const GAS f32x4*)(LOGF + (size_t)bh * SEQL))[tid];
            const float s1 = v.x, s2 = s1 + v.y, s3 = s2 + v.z, s4 = s3 + v.w;
            float incl = s4;
#pragma unroll
            for (int o = 1; o < 64; o <<= 1) { const float t = __shfl_up(incl, o); if (lane >= o) incl += t; }
            if (lane == 63) MISC[16 + wave] = __builtin_bit_cast(unsigned, incl);
            __syncthreads();
            float base = incl - s4;
            for (int w = 0; w < wave; ++w) base += __builtin_bit_cast(float, (unsigned)MISC[16 + w]);
            f32x4 o; o.x = (base + s1) * LOG2E; o.y = (base + s2) * LOG2E; o.z = (base + s3) * LOG2E; o.w = (base + s4) * LOG2E;
            ((GAS f32x4*)(C2G + (size_t)bh * SEQL))[tid] = o;
            __syncthreads();
        }
        pg8::StaticSched S; S.init(XN, WIN, M_TOK, 2048, 1024, G, bx);
        pg8::EpiSplit4 E{(pg8::bf16_t*)UB, (size_t)M_TOK * 512, fox::C2};
        pg8::gemm_phase<pg8::EpiSplit4, pg8::StaticSched, false, true>(L + RING_OFF, 1024, S, E, nullptr);
        if (BOTH(1)) GRID_BAR();
    }

    if (((MK_PHMASK >> 2) & 1) && IN(2)) {
        for (int un = vcu; un < NBATCH * NHD * 4; un += G) {
            const int bh = un >> 2, s = un & 3;
#pragma unroll 1
            for (int i = 0; i < 2; ++i) { const int qb = (i == 0) ? (7 - s) : s;
                fox::attn_unit(bh / NHD, bh % NHD, qb, (const fox::bf16*)QB_, (const fox::bf16*)KB, (const fox::bf16*)VB, C2G, (fox::bf16*)MIX, 512, (char*)lds + RING_OFF); }
        }
        for (int un = vcu; un < 64 * 4; un += G) {
            const int pm = un >> 2, g = un & 3, W = 2 << g;
            constexpr int RS = 272;
            LAS unsigned char* At = L + RING_OFF; LAS unsigned char* Bt = L + RING_OFF + 256 * RS;
            for (int i = tid; i < 128 * 16; i += NWAVES * 64) { const int n = i >> 4, c = i & 15; *(LAS v4u*)(Bt + n * RS + c * 16) = *(const GAS v4u*)(WPOOL + (size_t)g * 128 * 128 + n * 128 + c * 8); }
            { const int c = tid & 15, rg = tid >> 4; const int r0 = rg * 8; const int s0 = (pm & 7) * 256 + r0;
              const bf16* ub = UB + (size_t)(pm * 256 + r0) * 512 + g * 128 + c * 8;
              float run[8];
#pragma unroll
              for (int j = 0; j < 8; ++j) run[j] = 0.f;
              for (int j = 1; j < W; ++j) { if (s0 - j >= 0) { const v4u w = *(const GAS v4u*)(ub - (size_t)j * 512);
                  run[0] += bf_lo(w.x); run[1] += bf_hi(w.x); run[2] += bf_lo(w.y); run[3] += bf_hi(w.y); run[4] += bf_lo(w.z); run[5] += bf_hi(w.z); run[6] += bf_lo(w.w); run[7] += bf_hi(w.w); } }
#pragma unroll
              for (int i = 0; i < 8; ++i) {
                  const v4u w = *(const GAS v4u*)(ub + (size_t)i * 512);
                  float cur[8] = {bf_lo(w.x), bf_hi(w.x), bf_lo(w.y), bf_hi(w.y), bf_lo(w.z), bf_hi(w.z), bf_lo(w.w), bf_hi(w.w)};
#pragma unroll
                  for (int j = 0; j < 8; ++j) run[j] += cur[j];
                  const int sp = s0 + i; const float inv = 1.f / (float)((sp + 1 < W) ? sp + 1 : W);
                  v4u o; o.x = pk2(run[0] * inv - cur[0], run[1] * inv - cur[1]); o.y = pk2(run[2] * inv - cur[2], run[3] * inv - cur[3]);
                  o.z = pk2(run[4] * inv - cur[4], run[5] * inv - cur[5]); o.w = pk2(run[6] * inv - cur[6], run[7] * inv - cur[7]);
                  *(LAS v4u*)(At + (r0 + i) * RS + c * 16) = o;
                  if (sp - W + 1 >= 0) { const v4u z = *(const GAS v4u*)(ub + (long)(i - W + 1) * 512);
                      run[0] -= bf_lo(z.x); run[1] -= bf_hi(z.x); run[2] -= bf_lo(z.y); run[3] -= bf_hi(z.y); run[4] -= bf_lo(z.z); run[5] -= bf_hi(z.z); run[6] -= bf_lo(z.w); run[7] -= bf_hi(z.w); }
              } }
            __syncthreads();
            { const int r32 = lane & 31, hh = lane >> 5; f32x16 acc[4];
#pragma unroll
              for (int nb = 0; nb < 4; ++nb) acc[nb] = f32x16{};
#pragma unroll
              for (int ks = 0; ks < 8; ++ks) { const bf16x8 a = *(const LAS bf16x8*)(At + (wave * 32 + r32) * RS + (16 * ks + 8 * hh) * 2);
#pragma unroll
                  for (int nb = 0; nb < 4; ++nb) { const bf16x8 b = *(const LAS bf16x8*)(Bt + (nb * 32 + r32) * RS + (16 * ks + 8 * hh) * 2);
                      acc[nb] = __builtin_amdgcn_mfma_f32_32x32x16_bf16(a, b, acc[nb], 0, 0, 0); } }
#pragma unroll
              for (int nb = 0; nb < 4; ++nb) { const int n = g * 128 + nb * 32 + r32; const float sc = s_pool[n];
#pragma unroll
                  for (int r = 0; r < 16; ++r) { const int row = pm * 256 + wave * 32 + (r & 3) + 8 * (r >> 2) + 4 * hh; MIX[(size_t)row * 1024 + n] = (bf16)f2bf(acc[nb][r] * sc); } } }
            __syncthreads();
        }
        if (BOTH(2)) GRID_BAR();
    }

    if (((MK_PHMASK >> 3) & 1) && IN(3)) {
        pg8::StaticSched S; S.init(MIX, WOUT, M_TOK, 1024, 1024, G, bx);
        pg8::EpiResF32 E{x, H};
        pg8::gemm_phase<pg8::EpiResF32, pg8::StaticSched, false, true>(L + RING_OFF, 1024, S, E, nullptr);
        if (BOTH(3)) GRID_BAR();
    }

    if (((MK_PHMASK >> 4) & 1) && IN(4)) {
        LAS float* wl = (LAS float*)(L + 0);
        for (int i = tid; i < 36 * 256; i += NWAVES * 64) ((LAS f32x4*)wl)[i] = ((const GAS f32x4*)WRT)[i];
        LAS int* hist = (LAS int*)(L + LC_HIST); LAS int* hbase = (LAS int*)(L + LC_HBASE); LAS int* pend = (LAS int*)(L + LC_PEND);
        if (tid < 32) hist[tid] = 0;
        __syncthreads();
        f32x4 gf[4];
#pragma unroll
        for (int j = 0; j < 4; ++j) gf[j] = ((const GAS f32x4*)g_ffn)[lane + 64 * j];
        const float brt = b_rt[lane & 31], bgr = b_grp[lane & 3];
        const int rows_per_cu = M_TOK / G;
        for (int rr = wave; rr < rows_per_cu; rr += NWAVES) {
            const int m = vcu * rows_per_cu + rr;
            const GAS f32x4* hr = (const GAS f32x4*)(H + (size_t)m * DM) + lane;
            f32x4 v[4]; float s2 = 0.f;
#pragma unroll
            for (int j = 0; j < 4; ++j) { v[j] = hr[64 * j]; s2 += (v[j].x * v[j].x + v[j].y * v[j].y) + (v[j].z * v[j].z + v[j].w * v[j].w); }
            const float rstd = 1.f / sqrtf(wave_sum(s2) * (1.f / DM) + RMS_EPS);
#pragma unroll
            for (int j = 0; j < 4; ++j) v[j] = v[j] * rstd * gf[j];
            GAS unsigned long long* o8 = (GAS unsigned long long*)(XN + (size_t)m * DM) + lane;
#pragma unroll
            for (int j = 0; j < 4; ++j) o8[64 * j] = (unsigned long long)pk2(v[j].x, v[j].y) | ((unsigned long long)pk2(v[j].z, v[j].w) << 32);
            float part[36];
#pragma unroll
            for (int o = 0; o < 36; ++o) { float a = 0.f;
#pragma unroll
                for (int j = 0; j < 4; ++j) { const f32x4 w = *(const LAS f32x4*)(wl + o * 1024 + 4 * lane + 256 * j); a += (v[j].x * w.x + v[j].y * w.y) + (v[j].z * w.z + v[j].w * w.w); }
                part[o] = a; }
#pragma unroll
            for (int st = 0; st < 5; ++st) { const int msk = 16 >> st, half = 16 >> st; const bool up = (lane & msk) != 0;
#pragma unroll
                for (int i = 0; i < half; ++i) { const float keep = up ? part[i + half] : part[i], send = up ? part[i] : part[i + half]; part[i] = keep + __shfl_xor(send, msk); } }
            float elog = part[0] + __shfl_xor(part[0], 32);
            { const bool up1 = (lane & 2) != 0; const float k0 = up1 ? part[34] : part[32], s0 = up1 ? part[32] : part[34], k1 = up1 ? part[35] : part[33], s1 = up1 ? part[33] : part[35];
              const float a0 = k0 + __shfl_xor(s0, 2), a1 = k1 + __shfl_xor(s1, 2); const bool up0 = (lane & 1) != 0; const float kk = up0 ? a1 : a0, ss = up0 ? a0 : a1;
              float gl = kk + __shfl_xor(ss, 1);
#pragma unroll
              for (int o = 4; o < 64; o <<= 1) gl += __shfl_xor(gl, o);
              part[32] = gl + bgr; }
            elog += brt;
            const float g0 = __shfl(part[32], 0), g1 = __shfl(part[32], 1), g2 = __shfl(part[32], 2), g3 = __shfl(part[32], 3);
            int gi = 0; float gm = g0; if (g1 > gm) { gm = g1; gi = 1; } if (g2 > gm) { gm = g2; gi = 2; } if (g3 > gm) { gm = g3; gi = 3; }
            const float gw_ = 1.f / (__expf(g0 - gm) + __expf(g1 - gm) + __expf(g2 - gm) + __expf(g3 - gm));
            float sel[8];
#pragma unroll
            for (int j = 0; j < 8; ++j) sel[j] = __shfl(elog, gi * 8 + j);
            int i1 = 0; float v1 = sel[0];
#pragma unroll
            for (int j = 1; j < 8; ++j) if (sel[j] > v1) { v1 = sel[j]; i1 = j; }
            int i2 = -1; float v2 = -INFINITY;
#pragma unroll
            for (int j = 0; j < 8; ++j) if (j != i1 && sel[j] > v2) { v2 = sel[j]; i2 = j; }
            const float e2 = __expf(v2 - v1); const float w1 = gw_ / (1.f + e2), w2 = gw_ * e2 / (1.f + e2);
            if (lane == 0) { const int ex1 = gi * 8 + i1, ex2 = gi * 8 + i2;
                const int p1 = __hip_atomic_fetch_add(&hist[ex1], 1, __ATOMIC_RELAXED, __HIP_MEMORY_SCOPE_WORKGROUP), p2 = __hip_atomic_fetch_add(&hist[ex2], 1, __ATOMIC_RELAXED, __HIP_MEMORY_SCOPE_WORKGROUP);
                pend[(rr * 2 + 0) * 4 + 0] = ex1; pend[(rr * 2 + 0) * 4 + 1] = p1; pend[(rr * 2 + 0) * 4 + 2] = __builtin_bit_cast(int, w1); pend[(rr * 2 + 0) * 4 + 3] = m;
                pend[(rr * 2 + 1) * 4 + 0] = ex2; pend[(rr * 2 + 1) * 4 + 1] = p2; pend[(rr * 2 + 1) * 4 + 2] = __builtin_bit_cast(int, w2); pend[(rr * 2 + 1) * 4 + 3] = m; }
        }
        __syncthreads();
        if (tid < 32) { const int c = hist[tid]; hbase[tid] = c ? (int)__hip_atomic_fetch_add(GCNT + tid, (unsigned)c, RLX_AGENT) : 0; }
        __syncthreads();
        if (tid < rows_per_cu * 2) { const int e = pend[tid * 4 + 0], pos = hbase[e] + pend[tid * 4 + 1], m = pend[tid * 4 + 3];
            LIST[e * M_TOK + pos] = m; WL[e * M_TOK + pos] = __builtin_bit_cast(float, pend[tid * 4 + 2]);
            TOKPAIR[m * 4 + (tid & 1) * 2 + 0] = e; TOKPAIR[m * 4 + (tid & 1) * 2 + 1] = pos; }
        if (BOTH(4)) GRID_BAR();
    }

    if (IN(5) || IN(6) || IN(7)) {
        LAS int* lcnt = (LAS int*)(L + LC_CNT); LAS int* ltpre = (LAS int*)(L + LC_TPRE); LAS int* lcoff = (LAS int*)(L + LC_COFF); LAS int* tab = (LAS int*)(L + LC_TAB); LAS int* gidx = (LAS int*)(L + LC_GIDX);
        if (tid == 0) { int tp = 0, co = 0; for (int e = 0; e < NEXP; ++e) { const int c = (int)__hip_atomic_load(GCNT + e, RLX_AGENT); lcnt[e] = c; ltpre[e] = tp; lcoff[e] = co; tp += (c + 255) >> 8; co += c; } ltpre[NEXP] = tp; lcoff[NEXP] = co; }
        __syncthreads();
        if (tid < 4) { const int nwg = ltpre[NEXP] * 4; const long Lq = (long)tid * G + bx; int valid = 0, e = 0, mt = 0, pn = 0, rowbase = 0, nvalid = 0;
            if (Lq < nwg) { int wgid = (int)Lq; { const int q = nwg / 8, r = nwg % 8, xcd = wgid % 8, off = wgid / 8; wgid = (xcd < r ? xcd * (q + 1) : r * (q + 1) + (xcd - r) * q) + off; }
                while (e < NEXP - 1 && 4 * ltpre[e + 1] <= wgid) ++e;
                const int Te = ltpre[e + 1] - ltpre[e], loc = wgid - 4 * ltpre[e]; mt = loc % Te; pn = loc / Te; valid = 1;
                rowbase = lcoff[e] + mt * 256; nvalid = lcnt[e] - mt * 256; if (nvalid > 256) nvalid = 256; }
            tab[tid * 8 + 0] = valid; tab[tid * 8 + 1] = e; tab[tid * 8 + 2] = mt; tab[tid * 8 + 3] = pn; tab[tid * 8 + 4] = rowbase; tab[tid * 8 + 5] = nvalid; }
        __syncthreads();
    }
    if (((MK_PHMASK >> 5) & 1) && IN(5)) {
        LAS int* tab = (LAS int*)(L + LC_TAB); LAS int* gidx = (LAS int*)(L + LC_GIDX);
        for (int i = tid; i < 3 * 256; i += NWAVES * 64) { const int ui = i >> 8, r = i & 255; int row = 0;
            if (tab[ui * 8 + 0] && r < tab[ui * 8 + 5]) row = LIST[tab[ui * 8 + 1] * M_TOK + tab[ui * 8 + 2] * 256 + r];
            gidx[i] = row; }
        __syncthreads();
        pg8::MoeSched S{tab, (const char*)XN, (const char*)WGU, (size_t)1024 * 1024 * 2, (size_t)256 * 1024 * 2, 2048, true};
        pg8::EpiMoeAct E{(pg8::bf16_t*)ACT, WL};
        pg8::gemm_phase<pg8::EpiMoeAct, pg8::MoeSched, true, true>(L + RING_OFF, 1024, S, E, gidx);
        if (BOTH(5)) GRID_BAR();
    }
    if (((MK_PHMASK >> 6) & 1) && IN(6)) {
        LAS int* tab = (LAS int*)(L + LC_TAB);
        pg8::MoeSched S{tab, (const char*)ACT, (const char*)WDN, (size_t)1024 * 512 * 2, (size_t)256 * 512 * 2, 1024, false};
        pg8::EpiMoeDown E{(pg8::bf16_t*)YP};
        pg8::gemm_phase<pg8::EpiMoeDown, pg8::MoeSched, false, true>(L + RING_OFF, 512, S, E, nullptr);
        if (BOTH(6)) GRID_BAR();
    }

    if (((MK_PHMASK >> 7) & 1) && IN(7)) {
        LAS int* lcoff = (LAS int*)(L + LC_COFF);
        f32x4 gp[4];
#pragma unroll
        for (int j = 0; j < 4; ++j) gp[j] = ((const GAS f32x4*)g_ple)[lane + 64 * j];
        for (int m = gw; m < M_TOK; m += NGW) {
            const int e0 = TOKPAIR[m * 4 + 0], p0 = TOKPAIR[m * 4 + 1], e1 = TOKPAIR[m * 4 + 2], p1 = TOKPAIR[m * 4 + 3];
            const int s0 = lcoff[e0] + p0, s1 = lcoff[e1] + p1;
            GAS f32x4* hr = (GAS f32x4*)(H + (size_t)m * DM) + lane;
            const GAS v2u* y0 = (const GAS v2u*)(YP + (size_t)s0 * DM) + lane; const GAS v2u* y1 = (const GAS v2u*)(YP + (size_t)s1 * DM) + lane;
            f32x4 v[4]; float s2 = 0.f;
#pragma unroll
            for (int j = 0; j < 4; ++j) { v[j] = hr[64 * j]; const v2u a = y0[64 * j], b = y1[64 * j];
                v[j].x += bf_lo(a.x) + bf_lo(b.x); v[j].y += bf_hi(a.x) + bf_hi(b.x); v[j].z += bf_lo(a.y) + bf_lo(b.y); v[j].w += bf_hi(a.y) + bf_hi(b.y);
                hr[64 * j] = v[j]; s2 += (v[j].x * v[j].x + v[j].y * v[j].y) + (v[j].z * v[j].z + v[j].w * v[j].w); }
            const float rstd = 1.f / sqrtf(wave_sum(s2) * (1.f / DM) + RMS_EPS);
            GAS unsigned long long* o8 = (GAS unsigned long long*)(XN + (size_t)m * DM) + lane;
#pragma unroll
            for (int j = 0; j < 4; ++j) { const f32x4 t = v[j] * rstd * gp[j]; o8[64 * j] = (unsigned long long)pk2(t.x, t.y) | ((unsigned long long)pk2(t.z, t.w) << 32); }
            const f32x4 pv = ((const GAS f32x4*)(p_in + (size_t)m * PLED))[lane];
            ((GAS unsigned long long*)(PBF + (size_t)m * PLED))[lane] = (unsigned long long)pk2(pv.x, pv.y) | ((unsigned long long)pk2(pv.z, pv.w) << 32);
        }
        if (BOTH(7)) GRID_BAR();
    }

    if (((MK_PHMASK >> 8) & 1) && IN(8)) {
#ifndef MK_NO_P8A
        { pg8::StaticSched S; S.init(PBF, WPP, M_TOK, 1024, 256, G, bx);
          pg8::EpiBf16Plain E{(pg8::bf16_t*)PROJ, 1024};
          pg8::gemm_phase<pg8::EpiBf16Plain, pg8::StaticSched, false, true>(L + RING_OFF, 256, S, E, nullptr); }
#endif
        VM_WAIT();
#ifndef MK_NO_P8B
        { pg8::StaticSched S; S.init(XN, WPG, M_TOK, 1024, 1024, G, bx);
          pg8::EpiPle E{H, (const pg8::bf16_t*)PROJ};
          pg8::gemm_phase<pg8::EpiPle, pg8::StaticSched, false, true>(L + RING_OFF, 1024, S, E, nullptr); }
#endif
        if (BOTH(8)) GRID_BAR();
    }

    if (((MK_PHMASK >> 9) & 1) && IN(9)) {
        f32x4 gq[4];
#pragma unroll
        for (int j = 0; j < 4; ++j) gq[j] = ((const GAS f32x4*)g_final)[lane + 64 * j];
        for (int m = gw; m < M_TOK; m += NGW) {
            GAS f32x4* hr = (GAS f32x4*)(H + (size_t)m * DM) + lane;
            f32x4 v[4]; float s2 = 0.f;
#pragma unroll
            for (int j = 0; j < 4; ++j) { v[j] = hr[64 * j]; s2 += (v[j].x * v[j].x + v[j].y * v[j].y) + (v[j].z * v[j].z + v[j].w * v[j].w); }
            const float rstd = 1.f / sqrtf(wave_sum(s2) * (1.f / DM) + RMS_EPS);
#pragma unroll
            for (int j = 0; j < 4; ++j) hr[64 * j] = v[j] * rstd * gq[j];
        }
    }
#undef IN
#undef BOTH
#undef GRID_BAR
}
#ifndef MK_HYBRID
#define MK_HYBRID 0
#endif
#ifndef MK_PER_PHASE
#define MK_PER_PHASE 0
#endif
extern "C" void kernel_launch(void* const* d_in, const int* in_sizes, int n_in, void* d_out, int out_size, void* d_ws, size_t ws_size, hipStream_t stream) {
    static int grid = 0;
    if (grid == 0) {
        if (n_in != 20 || in_sizes[0] != M_TOK * DM || out_size != M_TOK * DM || ws_size < WS_END) { fprintf(stderr, "kernel_launch: unexpected shapes / workspace (%d inputs, ws %zu, need %zu); nothing launched\n", n_in, ws_size, (size_t)WS_END); grid = -1; return; }
        int dev = 0, cus = 0, per_cu = 0;
        if (hipGetDevice(&dev) != hipSuccess || hipDeviceGetAttribute(&cus, hipDeviceAttributeMultiprocessorCount, dev) != hipSuccess) { grid = -1; return; }
        if (hipFuncSetAttribute((const void*)mk_fwd, hipFuncAttributeMaxDynamicSharedMemorySize, LDS_BYTES) != hipSuccess) { fprintf(stderr, "kernel_launch: hipFuncSetAttribute(%d B LDS) failed\n", LDS_BYTES); grid = -1; return; }
        if (hipOccupancyMaxActiveBlocksPerMultiprocessor(&per_cu, (const void*)mk_fwd, NWAVES * 64, LDS_BYTES) != hipSuccess || per_cu < 1) { fprintf(stderr, "kernel_launch: occupancy query says %d blocks per CU; nothing launched\n", per_cu); (void)hipGetLastError(); grid = -1; return; }
        grid = cus;
        if (grid != 256) { fprintf(stderr, "kernel_launch: built for 256 CUs, found %d; nothing launched\n", cus); grid = -1; return; }
    }
    if (grid < 0) return;
    (void)hipMemsetAsync((char*)d_ws + WS_CTL, 0, CTL_ZERO_BYTES, stream);
    Args a{};
    for (int i = 0; i < 20; ++i) a.in[i] = (const float*)d_in[i];
    a.out = (float*)d_out; a.ws = (unsigned char*)d_ws;
    const int nmega = MK_HYBRID ? MK_HYBRID : NPHASE;
#if MK_PER_PHASE
    for (int ph = 0; ph < nmega; ++ph) { a.ph_lo = ph; a.ph_hi = ph + 1; a.li = ph; hipLaunchKernelGGL(mk_fwd, dim3(grid), dim3(NWAVES * 64), LDS_BYTES, stream, a); }
#else
    a.ph_lo = 0; a.ph_hi = nmega; a.li = 0;
    hipLaunchKernelGGL(mk_fwd, dim3(grid), dim3(NWAVES * 64), LDS_BYTES, stream, a);
#endif
#if MK_HYBRID
    {
        using namespace v1;
        const float* x = (const float*)d_in[0];      const float* p = (const float*)d_in[1];
        const float* g_ffn = (const float*)d_in[8];  const float* w_grp = (const float*)d_in[9];
        const float* b_grp = (const float*)d_in[10]; const float* w_rt = (const float*)d_in[11];
        const float* b_rt = (const float*)d_in[12];  const float* w_e_gate = (const float*)d_in[13];
        const float* w_e_up = (const float*)d_in[14]; const float* w_e_down = (const float*)d_in[15];
        const float* g_ple = (const float*)d_in[16]; const float* w_ple_gate = (const float*)d_in[17];
        const float* w_ple_proj = (const float*)d_in[18]; const float* g_final = (const float*)d_in[19];
        float* out = (float*)d_out; unsigned char* ws = (unsigned char*)d_ws; (void)x;
        float* Z0 = (float*)ws; float* Z1 = (float*)(ws + 64 * MiB); float* A = (float*)(ws + 136 * MiB); float* Dd = (float*)(ws + 200 * MiB);
        unsigned char* misc = ws + 232 * MiB;
        int* cnt = (int*)(misc + 1 * MiB); int* off = cnt + 64;
        float* lg = (float*)(misc + 1 * MiB + 4096); float* le = lg + NTOK * NG; int* tokpair = (int*)(le + NTOK * NE);
        int* list = (int*)(misc + 4 * MiB); float* wl = (float*)(misc + 6 * MiB);
        if (MK_HYBRID <= 4) {
            (void)hipMemsetAsync(cnt, 0, 512, stream);
            hipLaunchKernelGGL(rmsnorm_k, dim3(NTOK), dim3(256), 0, stream, out, g_ffn, A);
            sgemm(stream, A, D_MODEL, w_grp, NG, lg, NG, NTOK, NG, D_MODEL);
            sgemm(stream, A, D_MODEL, w_rt, NE, le, NE, NTOK, NE, D_MODEL);
            hipLaunchKernelGGL(router_select_k, dim3(NTOK / 256), dim3(256), 0, stream, lg, le, b_grp, b_rt, cnt, list, wl, tokpair);
            hipLaunchKernelGGL(offsets_k, dim3(1), dim3(64), 0, stream, cnt, off);
            float* Hg = Z0; float* Hu = Z1; float* Y = Z1;
            sgemm(stream, A, D_MODEL, w_e_gate, DEXP, Hg, DEXP, NTOK, DEXP, D_MODEL, nullptr, nullptr, 0, cnt, off, list, NTOK, (size_t)D_MODEL * DEXP, NE);
            sgemm(stream, A, D_MODEL, w_e_up, DEXP, Hu, DEXP, NTOK, DEXP, D_MODEL, nullptr, nullptr, 0, cnt, off, list, NTOK, (size_t)D_MODEL * DEXP, NE);
            hipLaunchKernelGGL(moe_act_k, dim3(NTOK * DEXP / 256, NE), dim3(256), 0, stream, Hg, Hu, cnt, off, wl);
            int* slotlist = (int*)Dd;
            hipLaunchKernelGGL(slotlist_k, dim3(NTOK / 256, NE), dim3(256), 0, stream, cnt, off, slotlist);
            sgemm(stream, Hg, DEXP, w_e_down, D_MODEL, Y, D_MODEL, NTOK, D_MODEL, DEXP, nullptr, nullptr, 0, cnt, off, slotlist, NTOK, (size_t)DEXP * D_MODEL, NE);
            hipLaunchKernelGGL(moe_combine_k, dim3(NTOK * D_MODEL / 256), dim3(256), 0, stream, out, Y, off, tokpair);
        }
        if (MK_HYBRID <= 8) {
            hipLaunchKernelGGL(rmsnorm_k, dim3(NTOK), dim3(256), 0, stream, out, g_ple, Z0);
            float* Gt = Z1; float* Pj = Z1 + (size_t)NTOK * D_MODEL;
            sgemm(stream, Z0, D_MODEL, w_ple_gate, D_MODEL, Gt, D_MODEL, NTOK, D_MODEL, D_MODEL);
            sgemm(stream, p, PLE_DIM, w_ple_proj, D_MODEL, Pj, D_MODEL, NTOK, D_MODEL, PLE_DIM);
            hipLaunchKernelGGL(ple_combine_k, dim3(NTOK * D_MODEL / 256), dim3(256), 0, stream, out, Gt, Pj);
        }
        hipLaunchKernelGGL(rmsnorm_k, dim3(NTOK), dim3(256), 0, stream, out, g_final, out);
    }
#endif
}
```

```cpp
#include <hip/hip_runtime.h>
#include <hip/hip_bf16.h>
#include <cstdio>
#include <cstdint>
namespace pg8 {
#define PG8_LAS __attribute__((address_space(3)))
typedef unsigned short bf16_t;
typedef short bf16x8 __attribute__((ext_vector_type(8)));
typedef float f32x4 __attribute__((ext_vector_type(4)));
typedef unsigned u32x4 __attribute__((ext_vector_type(4)));
typedef unsigned u32x2 __attribute__((ext_vector_type(2)));
constexpr int BM = 256, BK = 64, HALF = 128, HTB = HALF * BK * 2  , STAGE_BYTES = 8 * HTB, NXCD = 8, WGM = 8;

__host__ __device__ __forceinline__ int lds_byte(int r, int c) { const int st = (r >> 4) * 2 + (c >> 5), rr = r & 15, cc = c & 31, ob = rr * 64 + cc * 2; return st * 1024 + (ob ^ (((ob >> 9) & 1) << 5)); }
__host__ __device__ __forceinline__ void stage_rc(int b, int& R, int& C) { const int st = b / 1024, sb = b % 1024, swz = sb ^ (((sb >> 9) & 1) << 5); R = (st >> 1) * 16 + swz / 64; C = (st & 1) * 32 + (swz % 64) / 2; }
__host__ __device__ __forceinline__ int perm32(int rho) { const int n = rho >> 4, i = rho & 15; return 8 * (i >> 2) + 4 * n + (i & 3); }

struct Unit { int pm, pn; const char* a; const char* b; int x0, x1, x2, x3; };

__device__ __forceinline__ unsigned cvt_pk_bf16(float lo, float hi) { unsigned r; asm volatile("v_cvt_pk_bf16_f32 %0, %1, %2" : "=v"(r) : "v"(lo), "v"(hi)); return r; }

struct StaticSched {
    const char* A; const char* Bt; size_t tstep; int nM, nN, nwg, G, c;
    __device__ __forceinline__ void init(const void* A_, const void* Bt_, int M, int N, int K, int G_, int c_) { A = (const char*)A_; Bt = (const char*)Bt_; tstep = (size_t)BM * K * 2; nM = M / BM; nN = N / BM; nwg = nM * nN; G = G_; c = c_; }
    __device__ __forceinline__ bool next(int i, Unit& u) const {
        const long L = (long)i * G + c; if (L >= nwg) return false;
        int wgid = (int)L; { const int q = nwg / NXCD, r = nwg % NXCD, xcd = wgid % NXCD, off = wgid / NXCD; wgid = (xcd < r ? xcd * (q + 1) : r * (q + 1) + (xcd - r) * q) + off; }
        const int nig = WGM * nN, gid = wgid / nig, fm = gid * WGM, gsz = (nM - fm) < WGM ? (nM - fm) : WGM;
        u.pm = fm + ((wgid % nig) % gsz); u.pn = (wgid % nig) / gsz; u.a = A + (size_t)u.pm * tstep; u.b = Bt + (size_t)u.pn * tstep; u.x0 = u.x1 = u.x2 = u.x3 = 0; return true;
    }
};

template <class Epi, class Sched, bool GATHER, bool ALIGN_EPI>
__device__ __forceinline__ void gemm_phase(PG8_LAS unsigned char* lds, const int K, const Sched& S, const Epi& E, const PG8_LAS int* gidx) {
    const int tid = threadIdx.x, wid = __builtin_amdgcn_readfirstlane(tid >> 6), lane = tid & 63, wr = wid >> 2, wc = wid & 3, fr = lane & 15, fq = lane >> 4;
    const int nt = K / BK;
    unsigned voffB[2], vAc0[2], vAc1[2], vAn0[2], vAn1[2]; int Rr[2], Cc[2];
#pragma unroll
    for (int i = 0; i < 2; ++i) { int R, C; stage_rc(tid * 16 + i * 8192, R, C); const int Rb = Epi::PERM ? ((R & ~31) + perm32(R & 31)) : R; Rr[i] = R; Cc[i] = C; voffB[i] = (unsigned)(Rb * K + C) * 2u; }
#define PG8_SETA(v0, v1, ui_) do { _Pragma("unroll") for (int _i = 0; _i < 2; ++_i) { \
        const int r0_ = GATHER ? gidx[(ui_) * 256 + Rr[_i]] : Rr[_i]; const int r1_ = GATHER ? gidx[(ui_) * 256 + HALF + Rr[_i]] : (HALF + Rr[_i]); \
        v0[_i] = (unsigned)(r0_ * K + Cc[_i]) * 2u; v1[_i] = (unsigned)(r1_ * K + Cc[_i]) * 2u; } } while (0)
    const size_t kstep = (size_t)(BK * 2);
    const size_t hstep = (size_t)HALF * K * 2;
    const unsigned ldsw = (unsigned)wid * 1024u;
    const int aoff = lds_byte(wr * 64 + fr, fq * 8), boff = lds_byte(wc * 32 + fr, fq * 8);
#define PG8_SA(b, h) (((b) * 2 + (h)) * HTB)
#define PG8_SB(b, h) ((4 + (b) * 2 + (h)) * HTB)
#define PG8_STAGE(bufoff, gbase, voff) do { _Pragma("unroll") for (int _i = 0; _i < 2; ++_i) \
        __builtin_amdgcn_global_load_lds((const unsigned*)((const char*)(gbase) + (voff)[_i]), (PG8_LAS unsigned*)(lds + (bufoff) + ldsw + _i * 8192), 16, 0, 0); } while (0)
#define PG8_LDA(dst, b, h) do { _Pragma("unroll") for (int m = 0; m < 4; ++m) _Pragma("unroll") for (int k = 0; k < 2; ++k) dst[m][k] = *(const PG8_LAS bf16x8*)(lds + PG8_SA(b, h) + aoff + m * 2048 + k * 1024); } while (0)
#define PG8_LDB(dst, b, h) do { _Pragma("unroll") for (int n = 0; n < 2; ++n) _Pragma("unroll") for (int k = 0; k < 2; ++k) dst[n][k] = *(const PG8_LAS bf16x8*)(lds + PG8_SB(b, h) + boff + n * 2048 + k * 1024); } while (0)
#define PG8_MMA(ai, bj, At, Bt) do { __builtin_amdgcn_s_setprio(1); _Pragma("unroll") for (int m = 0; m < 4; ++m) _Pragma("unroll") for (int n = 0; n < 2; ++n) _Pragma("unroll") for (int k = 0; k < 2; ++k) \
        acc[ai][bj][m][n] = __builtin_amdgcn_mfma_f32_16x16x32_bf16(Bt[n][k], At[m][k], acc[ai][bj][m][n], 0, 0, 0); __builtin_amdgcn_s_setprio(0); } while (0)
#define PG8_WAIT_V(n) asm volatile("s_waitcnt vmcnt(" #n ")" ::: "memory")
#define PG8_WAIT_L(n) asm volatile("s_waitcnt lgkmcnt(" #n ")" ::: "memory")
#define PG8_BAR __builtin_amdgcn_s_barrier()
#define PG8_SCHED __builtin_amdgcn_sched_barrier(0)
    Unit cur, nxt; int ui = 0;
    if (!S.next(0, cur)) return;
    f32x4 acc[2][2][4][2];
#pragma unroll
    for (int a = 0; a < 2; ++a)
#pragma unroll
        for (int b = 0; b < 2; ++b)
#pragma unroll
            for (int m = 0; m < 4; ++m)
#pragma unroll
                for (int n = 0; n < 2; ++n) acc[a][b][m][n] = (f32x4){0.f, 0.f, 0.f, 0.f};
    bf16x8 At[4][2], B0[2][2], B1[2][2];
    const char* cA = cur.a; const char* cB = cur.b;
    PG8_SETA(vAc0, vAc1, 0);
    PG8_STAGE(PG8_SB(0, 0), cB, voffB); PG8_STAGE(PG8_SB(0, 1), cB + hstep, voffB); PG8_STAGE(PG8_SA(0, 0), cA, vAc0); PG8_STAGE(PG8_SA(0, 1), cA, vAc1);
    if (wr == 1) PG8_BAR;
    PG8_WAIT_V(2); PG8_BAR;
    PG8_STAGE(PG8_SB(1, 0), cB + kstep, voffB); PG8_STAGE(PG8_SA(1, 0), cA + kstep, vAc0); PG8_STAGE(PG8_SB(1, 1), cB + hstep + kstep, voffB);
    PG8_WAIT_V(6); PG8_BAR;
    for (;;) {
        const bool has_next = S.next(ui + 1, nxt);
        const char* nA = has_next ? nxt.a : cA; const char* nB = has_next ? nxt.b : cB;
        if (has_next) { PG8_SETA(vAn0, vAn1, ui + 1); } else { vAn0[0] = vAc0[0]; vAn0[1] = vAc0[1]; vAn1[0] = vAc1[0]; vAn1[1] = vAc1[1]; }
#pragma unroll 1
        for (int t = 0; t < nt; t += 2) {
            const bool last = (t == nt - 2);
            const char* a1 = cA + (size_t)(t + 1) * kstep;
            const char* a2 = last ? nA : cA + (size_t)(t + 2) * kstep; const char* b2 = last ? nB : cB + (size_t)(t + 2) * kstep;
            const char* a3 = a2 + kstep; const char* b3 = b2 + kstep;
            unsigned v20[2], v21[2];
            v20[0] = last ? vAn0[0] : vAc0[0]; v20[1] = last ? vAn0[1] : vAc0[1]; v21[0] = last ? vAn1[0] : vAc1[0]; v21[1] = last ? vAn1[1] : vAc1[1];
            PG8_LDB(B0, 0, 0); PG8_LDB(B1, 0, 1); PG8_SCHED; PG8_LDA(At, 0, 0); PG8_STAGE(PG8_SA(1, 1), a1, vAc1);
            PG8_WAIT_V(8); PG8_WAIT_L(0); PG8_BAR; PG8_MMA(0, 0, At, B0); PG8_MMA(0, 1, At, B1); PG8_BAR; PG8_SCHED;
            PG8_LDA(At, 0, 1); PG8_STAGE(PG8_SB(0, 0), b2, voffB); PG8_STAGE(PG8_SB(0, 1), b2 + hstep, voffB); PG8_STAGE(PG8_SA(0, 0), a2, v20);
            PG8_WAIT_V(8); PG8_WAIT_L(0); PG8_BAR; PG8_MMA(1, 0, At, B0); PG8_MMA(1, 1, At, B1); PG8_BAR; PG8_SCHED;
            PG8_LDB(B0, 1, 0); PG8_LDB(B1, 1, 1); PG8_SCHED; PG8_LDA(At, 1, 0); PG8_STAGE(PG8_SA(0, 1), a2, v21);
            PG8_WAIT_V(8); PG8_WAIT_L(0); PG8_BAR; PG8_MMA(0, 0, At, B0); PG8_MMA(0, 1, At, B1); PG8_BAR; PG8_SCHED;
            PG8_LDA(At, 1, 1); PG8_STAGE(PG8_SB(1, 0), b3, voffB); PG8_STAGE(PG8_SB(1, 1), b3 + hstep, voffB); PG8_STAGE(PG8_SA(1, 0), a3, v20);
            PG8_WAIT_V(8); PG8_WAIT_L(0); PG8_BAR; PG8_MMA(1, 0, At, B0); PG8_MMA(1, 1, At, B1); PG8_BAR; PG8_SCHED;
        }
        if constexpr (ALIGN_EPI) { if (wr == 0) PG8_BAR; }
        E(acc, cur, wr, wc, fr, fq);
        if (!has_next) break;
#pragma unroll
        for (int a = 0; a < 2; ++a)
#pragma unroll
            for (int b = 0; b < 2; ++b)
#pragma unroll
                for (int m = 0; m < 4; ++m)
#pragma unroll
                    for (int n = 0; n < 2; ++n) acc[a][b][m][n] = (f32x4){0.f, 0.f, 0.f, 0.f};
        cur = nxt; cA = nA; cB = nB; ++ui;
        vAc0[0] = vAn0[0]; vAc0[1] = vAn0[1]; vAc1[0] = vAn1[0]; vAc1[1] = vAn1[1];
        if constexpr (ALIGN_EPI) { if (wr == 1) PG8_BAR; }
    }
    PG8_WAIT_V(0);
    if constexpr (!ALIGN_EPI) { if (wr == 0) PG8_BAR; }
    PG8_BAR;
#undef PG8_SETA
#undef PG8_SA
#undef PG8_SB
#undef PG8_STAGE
#undef PG8_LDA
#undef PG8_LDB
#undef PG8_MMA
#undef PG8_WAIT_V
#undef PG8_WAIT_L
#undef PG8_BAR
#undef PG8_SCHED
}
}
namespace fox {
using bf16 = __hip_bfloat16;
using bf16x8 = __attribute__((ext_vector_type(8))) short;
using s16x4 = __attribute__((ext_vector_type(4))) short;
using f32x16 = __attribute__((ext_vector_type(16))) float;
using u32x4 = __attribute__((ext_vector_type(4))) unsigned;
typedef float f32x4v __attribute__((ext_vector_type(4)));
constexpr int SEQ = 2048, D = 64, PITCH = 512, OPITCH = 1024, NHEAD = 8;
constexpr int NW = 8, QBLK = 32, QB = QBLK * NW, KVBLK = 64, NQB = SEQ / QB;
constexpr int SLOTB = 8192, LDS_K = 0, LDS_V = 2 * SLOTB, LDS_C = 4 * SLOTB, LDS_WS = LDS_C + SEQ * 4, LDS_OST = LDS_WS + NW * 64 * 4, LDS_BYTES = LDS_OST + NW * 4096;
constexpr float C2 = 0.125f * 1.4426950408889634f;
__device__ __forceinline__ int crow(int r, int hi) { return (r & 3) + 8 * (r >> 2) + 4 * hi; }
#define FOX_SBAR() __builtin_amdgcn_sched_barrier(0)
__device__ __forceinline__ void cmask(f32x16& p0, f32x16& p1, int jb, int qrel, int hi) {
    const float NEG = -INFINITY; int kb = 64 * jb + 4 * hi;
#pragma unroll
    for (int r = 0; r < 16; ++r) { int kv = kb + (r & 3) + 8 * (r >> 2); if (kv > qrel) p0[r] = NEG; if (kv + 32 > qrel) p1[r] = NEG; }
}
__device__ __forceinline__ void glds16(const void* gsrc, unsigned lds_dst) { unsigned keep;
    asm volatile("s_mov_b32 %0, m0\n\ts_mov_b32 m0, %2\n\ts_nop 0\n\tglobal_load_lds_dwordx4 %1, off\n\ts_mov_b32 m0, %0" : "=&s"(keep) : "v"(gsrc), "s"(lds_dst) : "memory"); }
typedef float f32x2_t __attribute__((ext_vector_type(2))); typedef __bf16 bf16x2_t __attribute__((ext_vector_type(2)));
__device__ __forceinline__ unsigned cvtpk_s(float lo, float hi) { f32x2_t v = {lo, hi}; bf16x2_t b = __builtin_convertvector(v, bf16x2_t); return __builtin_bit_cast(unsigned, b); }
typedef __attribute__((address_space(3))) const char* lds_cptr;
__device__ __forceinline__ float rowmax(const f32x16& p0, const f32x16& p1) {
    float a = fmaxf(p0[0], p1[0]);
#pragma unroll
    for (int r = 1; r < 16; ++r) a = fmaxf(a, fmaxf(p0[r], p1[r]));
    return fmaxf(a, __shfl_xor(a, 32));
}
__device__ __forceinline__ void pv(f32x16* o, int vb, bf16x8 pa0, bf16x8 pa1, bf16x8 pa2, bf16x8 pa3) {
#pragma unroll
    for (int d0 = 0; d0 < 2; ++d0) { s16x4 lo[4], hi[4];
#pragma unroll
        for (int ks = 0; ks < 4; ++ks) {
            asm volatile("ds_read_b64_tr_b16 %0,%1 offset:%c2" : "=&v"(lo[ks]) : "v"(vb), "i"(d0 * 4096 + ks * 1024) : "memory");
            asm volatile("ds_read_b64_tr_b16 %0,%1 offset:%c2" : "=&v"(hi[ks]) : "v"(vb), "i"(d0 * 4096 + ks * 1024 + 512) : "memory"); }
        asm volatile("s_waitcnt lgkmcnt(0)" ::: "memory"); FOX_SBAR();
#define FOX_PK(k) (bf16x8){lo[k][0], lo[k][1], lo[k][2], lo[k][3], hi[k][0], hi[k][1], hi[k][2], hi[k][3]}
        o[d0] = __builtin_amdgcn_mfma_f32_32x32x16_bf16(pa0, FOX_PK(0), o[d0], 0, 0, 0);
        o[d0] = __builtin_amdgcn_mfma_f32_32x32x16_bf16(pa1, FOX_PK(1), o[d0], 0, 0, 0);
        o[d0] = __builtin_amdgcn_mfma_f32_32x32x16_bf16(pa2, FOX_PK(2), o[d0], 0, 0, 0);
        o[d0] = __builtin_amdgcn_mfma_f32_32x32x16_bf16(pa3, FOX_PK(3), o[d0], 0, 0, 0);
#undef FOX_PK
    }
}
#define FOX_WAIT_BAR(N) asm volatile("s_waitcnt vmcnt(" #N ") lgkmcnt(0)\n\ts_barrier" ::: "memory")

__device__ __forceinline__ void attn_unit(int b, int h, int qb, const bf16* Q, const bf16* __restrict__ K, const bf16* __restrict__ V, const float* __restrict__ c2g, bf16* O, int ocol0, char* shm) {
    const int tid = threadIdx.x, lane = tid & 63, r32 = lane & 31, hi = lane >> 5; const int wid = __builtin_amdgcn_readfirstlane(tid >> 6);
    const long rowbase = (long)b * SEQ; const int q0 = qb * QB;
    const bf16* Qw = Q + (rowbase + q0 + wid * QBLK) * PITCH + h * D;
    const bf16* Kh = K + rowbase * PITCH + h * D, *Vh = V + rowbase * PITCH + h * D;
    const unsigned lds0 = (unsigned)(uintptr_t)shm;
    float* wsf = (float*)(shm + LDS_WS) + wid * 64;
    float* cs = (float*)(shm + LDS_C);
    const bf16* ksrc = Kh + (long)lane * PITCH + wid * 8;
    const bf16* vsrc = Vh + (long)(16 * (wid & 3) + (lane >> 2)) * PITCH + (wid >> 2) * 32 + (lane & 3) * 8;
    const unsigned kdst = lds0 + LDS_K + wid * 1024, vdst = lds0 + LDS_V + wid * 1024;
#define FOX_DMA_K(t, slot) glds16(ksrc + (long)(t) * KVBLK * PITCH, (unsigned)__builtin_amdgcn_readfirstlane(kdst + (slot)))
#define FOX_DMA_V(t, slot) glds16(vsrc + (long)(t) * KVBLK * PITCH, (unsigned)__builtin_amdgcn_readfirstlane(vdst + (slot)))
    const int vb0 = (int)(lds0 + LDS_V) + ((lane >> 4) & 1) * 32 + (lane & 3) * 8 + (4 * hi + ((lane & 15) >> 2)) * 64;
    const lds_cptr kp0 = (lds_cptr)shm + LDS_K + hi * 1024 + r32 * 16;
    const int NT = (q0 + QB) / KVBLK;
    FOX_DMA_K(0, 0); FOX_DMA_V(0, 0);
    { const float* cg = c2g + (size_t)(b * NHEAD + h) * SEQ; for (int i = tid; i < q0 + QB; i += NW * 64) cs[i] = cg[i]; }
    bf16x8 qr[4];
#pragma unroll
    for (int d0 = 0; d0 < 4; ++d0) qr[d0] = *reinterpret_cast<const bf16x8*>(&Qw[(long)r32 * PITCH + d0 * 16 + hi * 8]);
    FOX_WAIT_BAR(0);
    const int qrel = wid * QBLK + r32;
    const float cq = cs[q0 + qrel];
    float m_run = -INFINITY, l_reg = 0.f; f32x16 o[2]; o[0] = f32x16{}; o[1] = f32x16{};
    for (int t = 0; t < NT; ++t) {
        const int slot = (t & 1) * SLOTB;
        if (t + 1 < NT) { FOX_DMA_K(t + 1, slot ^ SLOTB); FOX_DMA_V(t + 1, slot ^ SLOTB); FOX_WAIT_BAR(2); } else { FOX_WAIT_BAR(0); }
        f32x16 p0, p1;
#pragma unroll
        for (int g = 0; g < 4; ++g) { const f32x4v ca = *(const f32x4v*)(cs + t * KVBLK + 8 * g + 4 * hi), cb = *(const f32x4v*)(cs + t * KVBLK + 32 + 8 * g + 4 * hi);
#pragma unroll
            for (int j = 0; j < 4; ++j) { p0[4 * g + j] = cq - ca[j]; p1[4 * g + j] = cq - cb[j]; } }
        { const lds_cptr kb = kp0 + slot;
#pragma unroll
          for (int d0 = 0; d0 < 4; ++d0) {
              const bf16x8 b0 = *(const __attribute__((address_space(3))) bf16x8*)(kb + d0 * 2048);
              const bf16x8 b1 = *(const __attribute__((address_space(3))) bf16x8*)(kb + d0 * 2048 + 512);
              p0 = __builtin_amdgcn_mfma_f32_32x32x16_bf16(b0, qr[d0], p0, 0, 0, 0); p1 = __builtin_amdgcn_mfma_f32_32x32x16_bf16(b1, qr[d0], p1, 0, 0, 0); } }
        { const int jb = t - (NT - 4); if (jb >= 0) cmask(p0, p1, jb, qrel, hi); }
        const float rm = rowmax(p0, p1);
        const float m_new = fmaxf(m_run, rm);
        const float alpha = __builtin_amdgcn_exp2f(m_run - m_new);
        m_run = m_new;
        float sacc = 0.f;
#pragma unroll
        for (int r = 0; r < 16; ++r) { p0[r] = __builtin_amdgcn_exp2f(p0[r] - m_new); p1[r] = __builtin_amdgcn_exp2f(p1[r] - m_new); sacc += p0[r] + p1[r]; }
        l_reg = l_reg * alpha + sacc;
        if (hi == 0) wsf[r32] = alpha;
        asm volatile("s_waitcnt lgkmcnt(0)" ::: "memory");
#pragma unroll
        for (int d_ = 0; d_ < 2; ++d_)
#pragma unroll
            for (int r = 0; r < 16; ++r) o[d_][r] *= wsf[crow(r, hi)];
        u32x4 pw0, pw1, pw2, pw3;
#define FOX_PKW(P, B) cvtpk_s(P[B], P[B + 1])
        pw0 = (u32x4){FOX_PKW(p0, 0), FOX_PKW(p0, 2), FOX_PKW(p0, 4), FOX_PKW(p0, 6)}; pw1 = (u32x4){FOX_PKW(p0, 8), FOX_PKW(p0, 10), FOX_PKW(p0, 12), FOX_PKW(p0, 14)};
        pw2 = (u32x4){FOX_PKW(p1, 0), FOX_PKW(p1, 2), FOX_PKW(p1, 4), FOX_PKW(p1, 6)}; pw3 = (u32x4){FOX_PKW(p1, 8), FOX_PKW(p1, 10), FOX_PKW(p1, 12), FOX_PKW(p1, 14)};
#undef FOX_PKW
        FOX_SBAR();
        pv(o, vb0 + slot, __builtin_bit_cast(bf16x8, pw0), __builtin_bit_cast(bf16x8, pw1), __builtin_bit_cast(bf16x8, pw2), __builtin_bit_cast(bf16x8, pw3));
        asm volatile("s_waitcnt lgkmcnt(0)\n\ts_barrier" ::: "memory");
    }
    l_reg += __shfl_xor(l_reg, 32);
    if (hi == 0) wsf[32 + r32] = l_reg; asm volatile("s_waitcnt lgkmcnt(0)" ::: "memory");
    float rli[16];
#pragma unroll
    for (int r = 0; r < 16; ++r) rli[r] = 1.0f / wsf[32 + crow(r, hi)];
    bf16* Ow = O + (rowbase + q0 + wid * QBLK) * OPITCH + ocol0 + h * D;
    { bf16* stg = (bf16*)(shm + LDS_OST) + wid * 2048;
#pragma unroll
      for (int r = 0; r < 16; ++r) { const int orow = crow(r, hi);
#pragma unroll
          for (int d0 = 0; d0 < 2; ++d0) stg[orow * 64 + d0 * 32 + r32] = __float2bfloat16(o[d0][r] * rli[r]); }
      asm volatile("s_waitcnt lgkmcnt(0)" ::: "memory");
#pragma unroll
      for (int i = 0; i < 4; ++i) { const int row = i * 8 + (lane >> 3), ch = lane & 7; const u32x4 v = *(const u32x4*)(stg + row * 64 + ch * 8); *(u32x4*)(Ow + (long)row * OPITCH + ch * 8) = v; } }
    asm volatile("s_waitcnt vmcnt(0) lgkmcnt(0)\n\ts_barrier" ::: "memory");
#undef FOX_DMA_K
#undef FOX_DMA_V
}
#undef FOX_SBAR
#undef FOX_WAIT_BAR
}
constexpr int NWAVES = 8;
constexpr int M_TOK = 16384, DM = 1024, SEQL = 2048, NBATCH = 8, NHD = 8, HDIM = 64, ADIM = 512, PDIM = 512, PGD_ = 128, INDIM = 2056;
constexpr int NEXP = 32, FEXP = 512, PLED = 256;
constexpr float RMS_EPS = 1e-6f, LOG2E = 1.4426950408889634f;

constexpr size_t MiB = 1u << 20, KiB = 1u << 10;
constexpr size_t WS_CTL = 0, CTL_ZERO_BYTES = 256 * KiB;
constexpr size_t WS_WIN = 1 * MiB;
constexpr size_t WS_WOUT = 5 * MiB;
constexpr size_t WS_WPG = 7 * MiB;
constexpr size_t WS_WPP = 9 * MiB;
constexpr size_t WS_WPOOL = 9 * MiB + 512 * KiB;
constexpr size_t WS_WRT = 9 * MiB + 768 * KiB;
constexpr size_t WS_WF = 10 * MiB;
constexpr size_t WS_C2 = 10 * MiB + 512 * KiB;
constexpr size_t WS_LOGF = 11 * MiB;
constexpr size_t WS_TOKPAIR = 11 * MiB + 512 * KiB;
constexpr size_t WS_LIST = 12 * MiB;
constexpr size_t WS_WL = 14 * MiB;
constexpr size_t WS_WGU = 16 * MiB;
constexpr size_t WS_WDN = 80 * MiB;
constexpr size_t WS_XN = 112 * MiB;
constexpr size_t WS_U = 144 * MiB, WS_Q = 160 * MiB, WS_K = 176 * MiB, WS_V = 192 * MiB;
constexpr size_t WS_ACT = 144 * MiB;
constexpr size_t WS_PROJ = 177 * MiB;
constexpr size_t WS_PBF = 209 * MiB;
constexpr size_t WS_MIX = 217 * MiB;
constexpr size_t WS_YP = 217 * MiB;
constexpr size_t WS_END = 281 * MiB;
constexpr int CW_TMO = 0, CW_CNT = 2048, CW_BAR = 4096;

constexpr int RING_OFF = 0, RING_BYTES = 131072;
constexpr int LDSCTL_OFF = 147456;
constexpr int LC_MISC = LDSCTL_OFF, LC_CNT = LDSCTL_OFF + 128, LC_TPRE = LDSCTL_OFF + 256, LC_COFF = LDSCTL_OFF + 512, LC_TAB = LDSCTL_OFF + 768,
              LC_HIST = LDSCTL_OFF + 1024, LC_HBASE = LDSCTL_OFF + 1152, LC_PEND = LDSCTL_OFF + 2048, LC_GIDX = LDSCTL_OFF + 4096;
constexpr int LDS_BYTES = LDSCTL_OFF + 8192;

#define GAS __attribute__((address_space(1)))
#define LAS __attribute__((address_space(3)))
typedef unsigned short bf16;
typedef unsigned v4u __attribute__((ext_vector_type(4)));
typedef unsigned v2u __attribute__((ext_vector_type(2)));
typedef float f32x4 __attribute__((ext_vector_type(4)));
typedef short bf16x8 __attribute__((ext_vector_type(8)));
typedef float f32x16 __attribute__((ext_vector_type(16)));
typedef GAS unsigned gu32;
#define RLX_AGENT __ATOMIC_RELAXED, __HIP_MEMORY_SCOPE_AGENT
#define LDS_WAIT() asm volatile("s_waitcnt lgkmcnt(0)" ::: "memory")
#define VM_WAIT() asm volatile("s_waitcnt vmcnt(0)" ::: "memory")
__device__ __forceinline__ unsigned f2bf(float f) { unsigned u = __builtin_bit_cast(unsigned, f); return (u + 0x7fffu + ((u >> 16) & 1u)) >> 16; }
__device__ __forceinline__ unsigned pk2(float lo, float hi) { return f2bf(lo) | (f2bf(hi) << 16); }
__device__ __forceinline__ float bf_lo(unsigned w) { return __builtin_bit_cast(float, w << 16); }
__device__ __forceinline__ float bf_hi(unsigned w) { return __builtin_bit_cast(float, w & 0xffff0000u); }

#define XB_TMO      128
#define XB_XCNT(j)  (256  + 64 * (j))
#define XB_XSUB(j)  (1280 + 64 * (j))
#define XB_XGEN(j)  (2304 + 64 * (j))
#define XB_TOP      3328
#define XB_TOPGEN   3392
#define XCD_BAR_WORDS 3456
#define XB_SPIN_CAP (1u << 18)
__device__ __forceinline__ unsigned xb_ld(unsigned* p)              { return __hip_atomic_load(p, __ATOMIC_RELAXED, __HIP_MEMORY_SCOPE_AGENT); }
__device__ __forceinline__ unsigned xb_add(unsigned* p, unsigned v) { return __hip_atomic_fetch_add(p, v, __ATOMIC_RELAXED, __HIP_MEMORY_SCOPE_AGENT); }
__device__ __forceinline__ unsigned xb_xcc_id() { return (unsigned)__builtin_amdgcn_s_getreg((3 << 11) | 20) & 0xFu; }
#define XB_SPIN(cond, bar) do { unsigned _sp = 0; while (cond) { __builtin_amdgcn_s_sleep(1); \
    if ((++_sp & 255u) == 0u) { if (xb_ld(&(bar)[XB_TMO])) break; if (_sp > XB_SPIN_CAP) { atomicAdd(&(bar)[XB_TMO], 1u); break; } } } } while (0)
struct XcdBarrier { unsigned* bar; unsigned x; volatile LAS unsigned* st; };
__device__ __forceinline__ XcdBarrier xcd_barrier_post(unsigned* bar, volatile LAS unsigned* st) {
    XcdBarrier b; b.bar = bar; b.x = xb_xcc_id(); b.st = st;
    if (threadIdx.x == 0) (void)xb_add(&bar[XB_XCNT(b.x)], 1u);
    return b;
}
__device__ __forceinline__ void xcd_barrier_complete(unsigned* bar, unsigned x, unsigned& nloc, unsigned& nx) {
    const unsigned G = gridDim.x * gridDim.y * gridDim.z;
    unsigned sum, cnt, mine, sp = 0u;
    for (;;) {
        sum = 0u; cnt = 0u; mine = 0u;
#pragma unroll
        for (unsigned j = 0; j < 16; ++j) { const unsigned c = xb_ld(&bar[XB_XCNT(j)]); sum += c; cnt += (c > 0u) ? 1u : 0u; mine = (j == x) ? c : mine; }
        if (sum == G) break;
        __builtin_amdgcn_s_sleep(1);
        if ((++sp & 255u) == 0u) { if (xb_ld(&bar[XB_TMO])) break; if (sp > XB_SPIN_CAP) { atomicAdd(&bar[XB_TMO], 1u); break; } }
    }
    nloc = mine > 0u ? mine : 1u; nx = cnt > 0u ? cnt : 1u;
}
__device__ __forceinline__ void xcd_barrier(const XcdBarrier& b) {
    asm volatile("s_waitcnt vmcnt(0)" ::: "memory");
    __syncthreads();
    if (threadIdx.x == 0) {
        unsigned* bar = b.bar;
        __builtin_amdgcn_s_waitcnt(0);
        unsigned nloc = b.st[0], nx = b.st[1];
        if (nloc == 0u) { xcd_barrier_complete(bar, b.x, nloc, nx); b.st[0] = nloc; b.st[1] = nx; }
        const unsigned old = xb_add(&bar[XB_XSUB(b.x)], 1u);
        const unsigned gen = old / nloc;
        if (old + 1u == (gen + 1u) * nloc) {
            __builtin_amdgcn_fence(__ATOMIC_RELEASE, "agent");
            asm volatile("s_waitcnt vmcnt(0)" ::: "memory");
            const unsigned og = xb_add(&bar[XB_TOP], 1u);
            const unsigned tg = og / nx;
            if (og + 1u == (tg + 1u) * nx) xb_add(&bar[XB_TOPGEN], 1u);
            else XB_SPIN(xb_ld(&bar[XB_TOPGEN]) == tg, bar);
            __builtin_amdgcn_fence(__ATOMIC_ACQUIRE, "agent");
            xb_add(&bar[XB_XGEN(b.x)], 1u);
            asm volatile("s_waitcnt vmcnt(0)" ::: "memory");
        } else {
            XB_SPIN(xb_ld(&bar[XB_XGEN(b.x)]) == gen, bar);
            __builtin_amdgcn_fence(__ATOMIC_ACQUIRE, "agent");
            asm volatile("s_waitcnt vmcnt(0)" ::: "memory");
        }
    }
    __syncthreads();
}

namespace pg8 {
struct EpiSplit4 {
    static constexpr bool PERM = true;
    bf16_t* O; size_t stride; float qscale;
    __device__ __forceinline__ void operator()(const f32x4 (&acc)[2][2][4][2], const Unit& u, int wr, int wc, int fr, int fq) const {
        const int row0 = u.pm * BM + wr * 64 + fr; const int t = u.pn >> 1; bf16_t* base = O + (size_t)t * stride; const float sc = (t == 1) ? qscale : 1.f;
        const int col0 = (u.pn & 1) * BM + wc * 32 + 8 * fq;
#pragma unroll
        for (int ai = 0; ai < 2; ++ai)
#pragma unroll
            for (int m = 0; m < 4; ++m) { bf16_t* rowp = base + (size_t)(row0 + ai * HALF + m * 16) * 512 + col0;
#pragma unroll
                for (int bj = 0; bj < 2; ++bj) { const f32x4 v0 = acc[ai][bj][m][0] * sc, v1 = acc[ai][bj][m][1] * sc;
                    u32x4 w; w.x = cvt_pk_bf16(v0[0], v0[1]); w.y = cvt_pk_bf16(v0[2], v0[3]); w.z = cvt_pk_bf16(v1[0], v1[1]); w.w = cvt_pk_bf16(v1[2], v1[3]);
                    *(u32x4*)(rowp + bj * HALF) = w; } }
    }
};
struct EpiBf16Plain {
    static constexpr bool PERM = true;
    bf16_t* O; int ldc;
    __device__ __forceinline__ void operator()(const f32x4 (&acc)[2][2][4][2], const Unit& u, int wr, int wc, int fr, int fq) const {
        const int row0 = u.pm * BM + wr * 64 + fr, col0 = u.pn * BM + wc * 32 + 8 * fq;
#pragma unroll
        for (int ai = 0; ai < 2; ++ai)
#pragma unroll
            for (int m = 0; m < 4; ++m) { bf16_t* rowp = O + (size_t)(row0 + ai * HALF + m * 16) * ldc + col0;
#pragma unroll
                for (int bj = 0; bj < 2; ++bj) { const f32x4 v0 = acc[ai][bj][m][0], v1 = acc[ai][bj][m][1];
                    u32x4 w; w.x = cvt_pk_bf16(v0[0], v0[1]); w.y = cvt_pk_bf16(v0[2], v0[3]); w.z = cvt_pk_bf16(v1[0], v1[1]); w.w = cvt_pk_bf16(v1[2], v1[3]);
                    *(u32x4*)(rowp + bj * HALF) = w; } }
    }
};
struct EpiResF32 {
    static constexpr bool PERM = false;
    const float* X; float* H;
    __device__ __forceinline__ void operator()(const f32x4 (&acc)[2][2][4][2], const Unit& u, int wr, int wc, int fr, int fq) const {
        const int row0 = u.pm * BM + wr * 64 + fr, col0 = u.pn * BM + wc * 32 + 4 * fq;
#pragma unroll
        for (int ai = 0; ai < 2; ++ai)
#pragma unroll
            for (int m = 0; m < 4; ++m) { const size_t off = (size_t)(row0 + ai * HALF + m * 16) * 1024 + col0;
#pragma unroll
                for (int bj = 0; bj < 2; ++bj)
#pragma unroll
                    for (int n = 0; n < 2; ++n) *(f32x4*)(H + off + bj * HALF + n * 16) = *(const f32x4*)(X + off + bj * HALF + n * 16) + acc[ai][bj][m][n]; }
    }
};
__device__ __forceinline__ float silu_f(float g) { return g * __builtin_amdgcn_rcpf(1.f + __builtin_amdgcn_exp2f(-g * 1.4426950408889634f)); }
__device__ __forceinline__ float sigmoid_f(float g) { return __builtin_amdgcn_rcpf(1.f + __builtin_amdgcn_exp2f(-g * 1.4426950408889634f)); }
struct EpiMoeAct {
    static constexpr bool PERM = true;
    bf16_t* ACT; const float* WL;
    __device__ __forceinline__ void operator()(const f32x4 (&acc)[2][2][4][2], const Unit& u, int wr, int wc, int fr, int fq) const {
        const int col0 = u.pn * HALF + wc * 32 + 8 * fq;
#pragma unroll
        for (int ai = 0; ai < 2; ++ai)
#pragma unroll
            for (int m = 0; m < 4; ++m) { const int r = ai * HALF + wr * 64 + m * 16 + fr;
                if (r < u.x1) { const float w = WL[u.x2 + r]; const f32x4 g0 = acc[ai][0][m][0], g1 = acc[ai][0][m][1], u0 = acc[ai][1][m][0], u1 = acc[ai][1][m][1];
                    u32x4 o; o.x = cvt_pk_bf16(silu_f(g0[0]) * u0[0] * w, silu_f(g0[1]) * u0[1] * w); o.y = cvt_pk_bf16(silu_f(g0[2]) * u0[2] * w, silu_f(g0[3]) * u0[3] * w);
                    o.z = cvt_pk_bf16(silu_f(g1[0]) * u1[0] * w, silu_f(g1[1]) * u1[1] * w); o.w = cvt_pk_bf16(silu_f(g1[2]) * u1[2] * w, silu_f(g1[3]) * u1[3] * w);
                    *(u32x4*)(ACT + (size_t)(u.x0 + r) * 512 + col0) = o; } }
    }
};
struct EpiMoeDown {
    static constexpr bool PERM = true;
    bf16_t* YP;
    __device__ __forceinline__ void operator()(const f32x4 (&acc)[2][2][4][2], const Unit& u, int wr, int wc, int fr, int fq) const {
        const int col0 = u.pn * BM + wc * 32 + 8 * fq;
#pragma unroll
        for (int ai = 0; ai < 2; ++ai)
#pragma unroll
            for (int m = 0; m < 4; ++m) { const int r = ai * HALF + wr * 64 + m * 16 + fr;
                if (r < u.x1) { bf16_t* rowp = YP + (size_t)(u.x0 + r) * 1024 + col0;
#pragma unroll
                    for (int bj = 0; bj < 2; ++bj) { const f32x4 v0 = acc[ai][bj][m][0], v1 = acc[ai][bj][m][1];
                        u32x4 w; w.x = cvt_pk_bf16(v0[0], v0[1]); w.y = cvt_pk_bf16(v0[2], v0[3]); w.z = cvt_pk_bf16(v1[0], v1[1]); w.w = cvt_pk_bf16(v1[2], v1[3]);
                        *(u32x4*)(rowp + bj * HALF) = w; } } }
    }
};
struct EpiPle {
    static constexpr bool PERM = true;
    const float* H; float* HO; const bf16_t* PROJ;
    __device__ __forceinline__ void operator()(const f32x4 (&acc)[2][2][4][2], const Unit& u, int wr, int wc, int fr, int fq) const {
        const int row0 = u.pm * BM + wr * 64 + fr, col0 = u.pn * BM + wc * 32 + 8 * fq;
#pragma unroll
        for (int ai = 0; ai < 2; ++ai)
#pragma unroll
            for (int m = 0; m < 4; ++m) { const size_t off = (size_t)(row0 + ai * HALF + m * 16) * 1024 + col0;
#pragma unroll
                for (int bj = 0; bj < 2; ++bj) { const u32x4 pw = *(const u32x4*)(PROJ + off + bj * HALF);
                    const f32x4 h0 = *(const f32x4*)(H + off + bj * HALF), h1 = *(const f32x4*)(H + off + bj * HALF + 4); const f32x4 a0 = acc[ai][bj][m][0], a1 = acc[ai][bj][m][1];
                    f32x4 o0, o1;
                    o0[0] = h0[0] + sigmoid_f(a0[0]) * __builtin_bit_cast(float, pw.x << 16); o0[1] = h0[1] + sigmoid_f(a0[1]) * __builtin_bit_cast(float, pw.x & 0xffff0000u);
                    o0[2] = h0[2] + sigmoid_f(a0[2]) * __builtin_bit_cast(float, pw.y << 16); o0[3] = h0[3] + sigmoid_f(a0[3]) * __builtin_bit_cast(float, pw.y & 0xffff0000u);
                    o1[0] = h1[0] + sigmoid_f(a1[0]) * __builtin_bit_cast(float, pw.z << 16); o1[1] = h1[1] + sigmoid_f(a1[1]) * __builtin_bit_cast(float, pw.z & 0xffff0000u);
                    o1[2] = h1[2] + sigmoid_f(a1[2]) * __builtin_bit_cast(float, pw.w << 16); o1[3] = h1[3] + sigmoid_f(a1[3]) * __builtin_bit_cast(float, pw.w & 0xffff0000u);
                    *(f32x4*)(HO + off + bj * HALF) = o0; *(f32x4*)(HO + off + bj * HALF + 4) = o1; }
                asm volatile("" ::: "memory"); }
    }
};
struct MoeSched {
    const PG8_LAS int* tab; const char* A; const char* Bt; size_t estride, tstep; int Kb2; bool gather;
    __device__ __forceinline__ bool next(int i, Unit& u) const {
        if (i >= 4) return false;
        if (__builtin_amdgcn_readfirstlane(tab[i * 8 + 0]) == 0) return false;
        const int e = __builtin_amdgcn_readfirstlane(tab[i * 8 + 1]), mt = __builtin_amdgcn_readfirstlane(tab[i * 8 + 2]), pn = __builtin_amdgcn_readfirstlane(tab[i * 8 + 3]);
        const int rowbase = __builtin_amdgcn_readfirstlane(tab[i * 8 + 4]), nvalid = __builtin_amdgcn_readfirstlane(tab[i * 8 + 5]);
        u.pm = mt; u.pn = pn; u.b = Bt + (size_t)e * estride + (size_t)pn * tstep; u.a = gather ? A : A + (size_t)rowbase * Kb2;
        u.x0 = rowbase; u.x1 = nvalid; u.x2 = e * 16384 + mt * 256; u.x3 = e; return true;
    }
};
}
struct Args { const float* in[20]; float* out; unsigned char* ws; int ph_lo, ph_hi, li, pad; };
constexpr int NPHASE = 10;
#ifndef MK_REPEAT
#define MK_REPEAT -1
#endif
#define REPS(k) ((MK_REPEAT == (k)) ? 2 : 1)
#ifndef MK_PHMASK
#define MK_PHMASK 0x3ff
#endif

__device__ __forceinline__ float wave_sum(float v) {
#pragma unroll
    for (int o = 1; o < 64; o <<= 1) v += __shfl_xor(v, o);
    return v;
}
__device__ __forceinline__ void p0_transpose_item(const float* W, int ldw, int K, bf16* WT, int k0, int n0, int drow0, LAS float* scr, int lane) {
#pragma unroll 8
    for (int i = 0; i < 32; ++i) { const int kk = 2 * i + (lane >> 5); scr[kk * 33 + (lane & 31)] = W[(size_t)(k0 + kk) * ldw + n0 + (lane & 31)]; }
    LDS_WAIT(); asm volatile("" ::: "memory");
    const int c = lane & 7;
#pragma unroll
    for (int j = 0; j < 4; ++j) { const int n = (lane >> 3) + 8 * j; const LAS float* s = scr + (8 * c) * 33 + n;
        v4u o; o.x = pk2(s[0 * 33], s[1 * 33]); o.y = pk2(s[2 * 33], s[3 * 33]); o.z = pk2(s[4 * 33], s[5 * 33]); o.w = pk2(s[6 * 33], s[7 * 33]);
        *(GAS v4u*)(WT + (size_t)(drow0 + n) * K + k0 + 8 * c) = o; }
    LDS_WAIT(); asm volatile("" ::: "memory");
}

#define RS_STEP(P_, H_) { const bool up = (lane & (H_)) != 0; _Pragma("unroll") for (int i = 0; i < (H_); ++i) { const float keep = up ? P_[i + (H_)] : P_[i], send = up ? P_[i] : P_[i + (H_)]; P_[i] = keep + __shfl_xor(send, (H_)); } }
#define ROUTE_2ROWS(PA_, PB_, RQ_, MTOK_) do { \
    const bool hiH = lane >= 32; float q[32]; \
    _Pragma("unroll") for (int i = 0; i < 32; ++i) { const float keep = hiH ? PB_[i] : PA_[i], send = hiH ? PA_[i] : PB_[i]; q[i] = keep + __shfl_xor(send, 32); } \
    RS_STEP(q, 16) RS_STEP(q, 8) RS_STEP(q, 4) RS_STEP(q, 2) RS_STEP(q, 1) \
    float g4[4]; \
    _Pragma("unroll") for (int i = 0; i < 4; ++i) { const float keep = hiH ? PB_[32 + i] : PA_[32 + i], send = hiH ? PA_[32 + i] : PB_[32 + i]; g4[i] = keep + __shfl_xor(send, 32); } \
    RS_STEP(g4, 2) RS_STEP(g4, 1) \
    float gl = g4[0]; gl += __shfl_xor(gl, 4); gl += __shfl_xor(gl, 8); gl += __shfl_xor(gl, 16); \
    const float elog = q[0] + brt, glog = gl + bgr; const int hb = lane & 32; \
    const float g0 = __shfl(glog, hb + 0), g1 = __shfl(glog, hb + 1), g2 = __shfl(glog, hb + 2), g3 = __shfl(glog, hb + 3); \
    int gi = 0; float gm = g0; if (g1 > gm) { gm = g1; gi = 1; } if (g2 > gm) { gm = g2; gi = 2; } if (g3 > gm) { gm = g3; gi = 3; } \
    const float gw_ = 1.f / (__expf(g0 - gm) + __expf(g1 - gm) + __expf(g2 - gm) + __expf(g3 - gm)); \
    float sel[8]; \
    _Pragma("unroll") for (int j = 0; j < 8; ++j) sel[j] = __shfl(elog, hb + gi * 8 + j); \
    int i1 = 0; float v1 = sel[0]; \
    _Pragma("unroll") for (int j = 1; j < 8; ++j) if (sel[j] > v1) { v1 = sel[j]; i1 = j; } \
    int i2 = -1; float v2 = -INFINITY; \
    _Pragma("unroll") for (int j = 0; j < 8; ++j) if (j != i1 && sel[j] > v2) { v2 = sel[j]; i2 = j; } \
    const float e2 = __expf(v2 - v1); const float w1 = gw_ / (1.f + e2), w2 = gw_ * e2 / (1.f + e2); \
    if ((lane & 31) == 0) { const int ex1 = gi * 8 + i1, ex2 = gi * 8 + i2, rq_ = (RQ_) + (lane >> 5), mt_ = (MTOK_) + (lane >> 5); \
        const int p1 = __hip_atomic_fetch_add(&hist[ex1], 1, __ATOMIC_RELAXED, __HIP_MEMORY_SCOPE_WORKGROUP), p2 = __hip_atomic_fetch_add(&hist[ex2], 1, __ATOMIC_RELAXED, __HIP_MEMORY_SCOPE_WORKGROUP); \
        pend[(rq_ * 2 + 0) * 4 + 0] = ex1; pend[(rq_ * 2 + 0) * 4 + 1] = p1; pend[(rq_ * 2 + 0) * 4 + 2] = __builtin_bit_cast(int, w1); pend[(rq_ * 2 + 0) * 4 + 3] = mt_; \
        pend[(rq_ * 2 + 1) * 4 + 0] = ex2; pend[(rq_ * 2 + 1) * 4 + 1] = p2; pend[(rq_ * 2 + 1) * 4 + 2] = __builtin_bit_cast(int, w2); pend[(rq_ * 2 + 1) * 4 + 3] = mt_; } \
} while (0)

__global__ void __launch_bounds__(NWAVES * 64, 2) mk_fwd(Args args) {
    extern __shared__ __attribute__((aligned(16))) unsigned char lds[];
    LAS unsigned char* L = (LAS unsigned char*)lds;
    const int tid = threadIdx.x, lane = tid & 63, wave = __builtin_amdgcn_readfirstlane(tid >> 6);
    const int G = gridDim.x; const int bx = blockIdx.x; const int vcu = (G % 8 == 0) ? (bx % 8) * (G / 8) + bx / 8 : bx;
    unsigned char* ws = args.ws;
    gu32* ctl = (gu32*)(ws + WS_CTL);
    const float* x = args.in[0]; const float* p_in = args.in[1]; const float* g_mix = args.in[2]; const float* w_in = args.in[3]; const float* b_f = args.in[4];
    const float* w_pool = args.in[5]; const float* s_pool = args.in[6]; const float* w_out = args.in[7]; const float* g_ffn = args.in[8]; const float* w_grp = args.in[9];
    const float* b_grp = args.in[10]; const float* w_rt = args.in[11]; const float* b_rt = args.in[12]; const float* w_e_gate = args.in[13]; const float* w_e_up = args.in[14];
    const float* w_e_down = args.in[15]; const float* g_ple = args.in[16]; const float* w_ple_gate = args.in[17]; const float* w_ple_proj = args.in[18]; const float* g_final = args.in[19];
    float* H = args.out;
    bf16* WIN = (bf16*)(ws + WS_WIN); bf16* WOUT = (bf16*)(ws + WS_WOUT); bf16* WPG = (bf16*)(ws + WS_WPG); bf16* WPP = (bf16*)(ws + WS_WPP); bf16* WPOOL = (bf16*)(ws + WS_WPOOL);
    float* WRT = (float*)(ws + WS_WRT); float* WF = (float*)(ws + WS_WF); float* C2G = (float*)(ws + WS_C2); float* LOGF = (float*)(ws + WS_LOGF);
    int* TOKPAIR = (int*)(ws + WS_TOKPAIR); int* LIST = (int*)(ws + WS_LIST); float* WL = (float*)(ws + WS_WL);
    bf16* WGU = (bf16*)(ws + WS_WGU); bf16* WDN = (bf16*)(ws + WS_WDN); bf16* XN = (bf16*)(ws + WS_XN);
    bf16* UB = (bf16*)(ws + WS_U); bf16* QB_ = (bf16*)(ws + WS_Q); bf16* KB = (bf16*)(ws + WS_K); bf16* VB = (bf16*)(ws + WS_V);
    bf16* ACT = (bf16*)(ws + WS_ACT); bf16* PROJ = (bf16*)(ws + WS_PROJ); bf16* PBF = (bf16*)(ws + WS_PBF); bf16* MIX = (bf16*)(ws + WS_MIX); bf16* YP = (bf16*)(ws + WS_YP);
    unsigned* GCNT = (unsigned*)(ctl + CW_CNT);

    for (int u = tid; u < (LDS_BYTES - LDSCTL_OFF) / 4; u += NWAVES * 64) ((LAS unsigned*)(L + LDSCTL_OFF))[u] = 0u;
    __syncthreads();
    volatile LAS unsigned* MISC = (volatile LAS unsigned*)(L + LC_MISC);
    XcdBarrier bar = xcd_barrier_post((unsigned*)(ctl + CW_BAR) + args.li * XCD_BAR_WORDS, MISC + 8);
    const int lo = args.ph_lo, hi = args.ph_hi;
#define IN(k) (lo <= (k) && (k) < hi)
#define BOTH(k) (IN(k) && IN((k) + 1))
#define GRID_BAR() xcd_barrier(bar)
    const int gw = vcu * NWAVES + wave, NGW = G * NWAVES;

    if (((MK_PHMASK >> 0) & 1) && IN(0)) {
#pragma unroll 1
      for (int rep_ = 0; rep_ < REPS(0); ++rep_) {
        LAS float* scr = (LAS float*)(L + RING_OFF + wave * 16384);
        constexpr int I_IN = 16 * 64, I_OUT = 16 * 32, I_PG = 16 * 32, I_PP = 4 * 32, I_POOL = 4 * 2 * 4, I_G = 32 * 16 * 16, I_U = I_G, I_D = 32 * 8 * 32;
        constexpr int NITEMS = I_IN + I_OUT + I_PG + I_PP + I_POOL + I_G + I_U + I_D;
        for (int it = gw; it < NITEMS; it += NGW) {
            int r = it;
            if (r < I_IN) { const int kb = r / 64, nb = r % 64; p0_transpose_item(w_in, INDIM, 1024, WIN, 64 * kb, 32 * nb, 32 * nb, scr, lane); continue; } r -= I_IN;
            if (r < I_OUT) { const int kb = r / 32, nb = r % 32; p0_transpose_item(w_out, 1024, 1024, WOUT, 64 * kb, 32 * nb, 32 * nb, scr, lane); continue; } r -= I_OUT;
            if (r < I_PG) { const int kb = r / 32, nb = r % 32; p0_transpose_item(w_ple_gate, 1024, 1024, WPG, 64 * kb, 32 * nb, 32 * nb, scr, lane); continue; } r -= I_PG;
            if (r < I_PP) { const int kb = r / 32, nb = r % 32; p0_transpose_item(w_ple_proj, 1024, 256, WPP, 64 * kb, 32 * nb, 32 * nb, scr, lane); continue; } r -= I_PP;
            if (r < I_POOL) { const int g = r / 8, q = r % 8, kb = q / 4, nb = q % 4; p0_transpose_item(w_pool + (size_t)g * 128 * 128, 128, 128, WPOOL + (size_t)g * 128 * 128, 64 * kb, 32 * nb, 32 * nb, scr, lane); continue; } r -= I_POOL;
            if (r < I_G) { const int e = r / 256, q = r % 256, kb = q / 16, nb = q % 16, n0 = 32 * nb; p0_transpose_item(w_e_gate + (size_t)e * 1024 * 512, 512, 1024, WGU + (size_t)e * 1024 * 1024, 64 * kb, n0, (n0 >> 7) * 256 + (n0 & 127), scr, lane); continue; } r -= I_G;
            if (r < I_U) { const int e = r / 256, q = r % 256, kb = q / 16, nb = q % 16, n0 = 32 * nb; p0_transpose_item(w_e_up + (size_t)e * 1024 * 512, 512, 1024, WGU + (size_t)e * 1024 * 1024, 64 * kb, n0, (n0 >> 7) * 256 + 128 + (n0 & 127), scr, lane); continue; } r -= I_U;
            { const int e = r / 256, q = r % 256, kb = q / 32, nb = q % 32; p0_transpose_item(w_e_down + (size_t)e * 512 * 1024, 1024, 512, WDN + (size_t)e * 1024 * 512, 64 * kb, 32 * nb, 32 * nb, scr, lane); }
        }
        for (int i = gw * 64 + lane; i < 36 * 1024; i += NGW * 64) { const int o = i >> 10, k = i & 1023; WRT[i] = (o < 32) ? w_rt[k * 32 + o] : w_grp[k * 4 + (o - 32)]; }
        __syncthreads();
        LAS float* wf = (LAS float*)(L + RING_OFF);
        for (int i = tid; i < 8 * 1024; i += NWAVES * 64) { const int k = i >> 3, h = i & 7; wf[h * 1024 + k] = w_in[(size_t)k * INDIM + 2048 + h]; }
        __syncthreads();
        f32x4 gm[4];
#pragma unroll
        for (int j = 0; j < 4; ++j) gm[j] = ((const GAS f32x4*)g_mix)[lane + 64 * j];
        const float bfl = b_f[lane & 7];
#pragma unroll 1
        for (int m = 2 * gw; m < M_TOK; m += 2 * NGW) {
            const GAS f32x4* xr = (const GAS f32x4*)(x + (size_t)m * DM) + lane;
            f32x4 va[4], vb[4]; float s2a = 0.f, s2b = 0.f;
#pragma unroll
            for (int j = 0; j < 4; ++j) { va[j] = xr[64 * j]; vb[j] = xr[256 + 64 * j]; }
#pragma unroll
            for (int j = 0; j < 4; ++j) { s2a += (va[j].x * va[j].x + va[j].y * va[j].y) + (va[j].z * va[j].z + va[j].w * va[j].w); s2b += (vb[j].x * vb[j].x + vb[j].y * vb[j].y) + (vb[j].z * vb[j].z + vb[j].w * vb[j].w); }
            const float rsa = 1.f / sqrtf(wave_sum(s2a) * (1.f / DM) + RMS_EPS), rsb = 1.f / sqrtf(wave_sum(s2b) * (1.f / DM) + RMS_EPS);
#pragma unroll
            for (int j = 0; j < 4; ++j) { va[j] = va[j] * rsa * gm[j]; vb[j] = vb[j] * rsb * gm[j]; }
            GAS unsigned long long* o8 = (GAS unsigned long long*)(XN + (size_t)m * DM) + lane;
#pragma unroll
            for (int j = 0; j < 4; ++j) { o8[64 * j] = (unsigned long long)pk2(va[j].x, va[j].y) | ((unsigned long long)pk2(va[j].z, va[j].w) << 32);
                o8[256 + 64 * j] = (unsigned long long)pk2(vb[j].x, vb[j].y) | ((unsigned long long)pk2(vb[j].z, vb[j].w) << 32); }
            float fla = 0.f, flb = 0.f;
#pragma unroll
            for (int h = 0; h < 8; ++h) { float a = 0.f, b = 0.f;
#pragma unroll
                for (int j = 0; j < 4; ++j) { const f32x4 w = *(const LAS f32x4*)(wf + h * 1024 + 4 * lane + 256 * j);
                    a += (va[j].x * w.x + va[j].y * w.y) + (va[j].z * w.z + va[j].w * w.w); b += (vb[j].x * w.x + vb[j].y * w.y) + (vb[j].z * w.z + vb[j].w * w.w); }
                a = wave_sum(a); b = wave_sum(b); if ((lane & 7) == h) { fla = a; flb = b; } }
            if (lane < 16) { const float xl = ((lane < 8) ? fla : flb) + bfl; const float lf = fminf(xl, 0.f) - log1pf(__expf(-fabsf(xl)));
                const int mm = m + (lane >> 3); const int b = mm / SEQL, sq = mm % SEQL; LOGF[(size_t)(b * NHD + (lane & 7)) * SEQL + sq] = lf; }
        }
        if (rep_ + 1 < REPS(0)) GRID_BAR();
      }
        if (BOTH(0)) GRID_BAR();
    }

    if (((MK_PHMASK >> 1) & 1) && IN(1)) {
#pragma unroll 1
      for (int rep_ = 0; rep_ < REPS(1); ++rep_) {
        for (int bh = vcu; bh < NBATCH * NHD; bh += G) {
            const f32x4 v = ((const GAS f32x4*)(LOGF + (size_t)bh * SEQL))[tid];
            const float s1 = v.x, s2 = s1 + v.y, s3 = s2 + v.z, s4 = s3 + v.w;
            float incl = s4;
#pragma unroll
            for (int o = 1; o < 64; o <<= 1) { const float t = __shfl_up(incl, o); if (lane >= o) incl += t; }
            if (lane == 63) MISC[16 + wave] = __builtin_bit_cast(unsigned, incl);
            __syncthreads();
            float base = incl - s4;
            for (int w = 0; w < wave; ++w) base += __builtin_bit_cast(float, (unsigned)MISC[16 + w]);
            f32x4 o; o.x = (base + s1) * LOG2E; o.y = (base + s2) * LOG2E; o.z = (base + s3) * LOG2E; o.w = (base + s4) * LOG2E;
            ((GAS f32x4*)(C2G + (size_t)bh * SEQL))[tid] = o;
            __syncthreads();
        }
        pg8::StaticSched S; S.init(XN, WIN, M_TOK, 2048, 1024, G, bx);
        pg8::EpiSplit4 E{(pg8::bf16_t*)UB, (size_t)M_TOK * 512, fox::C2};
        pg8::gemm_phase<pg8::EpiSplit4, pg8::StaticSched, false, true>(L + RING_OFF, 1024, S, E, nullptr);
        if (rep_ + 1 < REPS(1)) GRID_BAR();
      }
        if (BOTH(1)) GRID_BAR();
    }

    if (((MK_PHMASK >> 2) & 1) && IN(2)) {
#pragma unroll 1
      for (int rep_ = 0; rep_ < REPS(2); ++rep_) {
        for (int un = vcu; un < NBATCH * NHD * 4; un += G) {
            const int bh = un >> 2, s = un & 3;
#pragma unroll 1
            for (int i = 0; i < 2; ++i) { const int qb = (i == 0) ? (7 - s) : s;
                fox::attn_unit(bh / NHD, bh % NHD, qb, (const fox::bf16*)QB_, (const fox::bf16*)KB, (const fox::bf16*)VB, C2G, (fox::bf16*)MIX, 512, (char*)lds + RING_OFF); }
        }
        for (int un = vcu; un < 64 * 4; un += G) {
            const int pm = un >> 2, g = un & 3, W = 2 << g;
            constexpr int RS = 272;
            LAS unsigned char* At = L + RING_OFF; LAS unsigned char* Bt = L + RING_OFF + 256 * RS;
            for (int i = tid; i < 128 * 16; i += NWAVES * 64) { const int n = i >> 4, c = i & 15; *(LAS v4u*)(Bt + n * RS + c * 16) = *(const GAS v4u*)(WPOOL + (size_t)g * 128 * 128 + n * 128 + c * 8); }
            { const int c = tid & 15, rg = tid >> 4; const int r0 = rg * 8; const int s0 = (pm & 7) * 256 + r0;
              const bf16* ub = UB + (size_t)(pm * 256 + r0) * 512 + g * 128 + c * 8;
              float run[8];
#pragma unroll
              for (int j = 0; j < 8; ++j) run[j] = 0.f;
              for (int j = 1; j < W; ++j) { if (s0 - j >= 0) { const v4u w = *(const GAS v4u*)(ub - (size_t)j * 512);
                  run[0] += bf_lo(w.x); run[1] += bf_hi(w.x); run[2] += bf_lo(w.y); run[3] += bf_hi(w.y); run[4] += bf_lo(w.z); run[5] += bf_hi(w.z); run[6] += bf_lo(w.w); run[7] += bf_hi(w.w); } }
#pragma unroll
              for (int i = 0; i < 8; ++i) {
                  const v4u w = *(const GAS v4u*)(ub + (size_t)i * 512);
                  float cur[8] = {bf_lo(w.x), bf_hi(w.x), bf_lo(w.y), bf_hi(w.y), bf_lo(w.z), bf_hi(w.z), bf_lo(w.w), bf_hi(w.w)};
#pragma unroll
                  for (int j = 0; j < 8; ++j) run[j] += cur[j];
                  const int sp = s0 + i; const float inv = 1.f / (float)((sp + 1 < W) ? sp + 1 : W);
                  v4u o; o.x = pk2(run[0] * inv - cur[0], run[1] * inv - cur[1]); o.y = pk2(run[2] * inv - cur[2], run[3] * inv - cur[3]);
                  o.z = pk2(run[4] * inv - cur[4], run[5] * inv - cur[5]); o.w = pk2(run[6] * inv - cur[6], run[7] * inv - cur[7]);
                  *(LAS v4u*)(At + (r0 + i) * RS + c * 16) = o;
                  if (sp - W + 1 >= 0) { const v4u z = *(const GAS v4u*)(ub + (long)(i - W + 1) * 512);
                      run[0] -= bf_lo(z.x); run[1] -= bf_hi(z.x); run[2] -= bf_lo(z.y); run[3] -= bf_hi(z.y); run[4] -= bf_lo(z.z); run[5] -= bf_hi(z.z); run[6] -= bf_lo(z.w); run[7] -= bf_hi(z.w); }
              } }
            __syncthreads();
            { const int r32 = lane & 31, hh = lane >> 5; f32x16 acc[4];
#pragma unroll
              for (int nb = 0; nb < 4; ++nb) acc[nb] = f32x16{};
#pragma unroll
              for (int ks = 0; ks < 8; ++ks) { const bf16x8 a = *(const LAS bf16x8*)(At + (wave * 32 + r32) * RS + (16 * ks + 8 * hh) * 2);
#pragma unroll
                  for (int nb = 0; nb < 4; ++nb) { const bf16x8 b = *(const LAS bf16x8*)(Bt + (nb * 32 + r32) * RS + (16 * ks + 8 * hh) * 2);
                      acc[nb] = __builtin_amdgcn_mfma_f32_32x32x16_bf16(a, b, acc[nb], 0, 0, 0); } }
#pragma unroll
              for (int nb = 0; nb < 4; ++nb) { const int n = g * 128 + nb * 32 + r32; const float sc = s_pool[n];
#pragma unroll
                  for (int r = 0; r < 16; ++r) { const int row = pm * 256 + wave * 32 + (r & 3) + 8 * (r >> 2) + 4 * hh; MIX[(size_t)row * 1024 + n] = (bf16)f2bf(acc[nb][r] * sc); } } }
            __syncthreads();
        }
        if (rep_ + 1 < REPS(2)) GRID_BAR();
      }
        if (BOTH(2)) GRID_BAR();
    }

    if (((MK_PHMASK >> 3) & 1) && IN(3)) {
#pragma unroll 1
      for (int rep_ = 0; rep_ < REPS(3); ++rep_) {
        pg8::StaticSched S; S.init(MIX, WOUT, M_TOK, 1024, 1024, G, bx);
        pg8::EpiResF32 E{x, H};
        pg8::gemm_phase<pg8::EpiResF32, pg8::StaticSched, false, true>(L + RING_OFF, 1024, S, E, nullptr);
        if (rep_ + 1 < REPS(3)) GRID_BAR();
      }
        if (BOTH(3)) GRID_BAR();
    }

    if (((MK_PHMASK >> 4) & 1) && IN(4)) {
#pragma unroll 1
      for (int dry = REPS(4) - 1; dry >= 0; --dry) {
        bf16* XNd = dry ? (bf16*)(ws + WS_U) : XN; int* LISTd = dry ? (int*)(ws + WS_K) : LIST; float* WLd = dry ? (float*)(ws + WS_K + 4 * MiB) : WL; int* TOKd = dry ? (int*)(ws + WS_K + 8 * MiB) : TOKPAIR;
        unsigned* GCNTd = dry ? GCNT + 64 : GCNT;
        LAS float* wl = (LAS float*)(L + 0);
        for (int i = tid; i < 36 * 256; i += NWAVES * 64) ((LAS f32x4*)wl)[i] = ((const GAS f32x4*)WRT)[i];
        LAS int* hist = (LAS int*)(L + LC_HIST); LAS int* hbase = (LAS int*)(L + LC_HBASE); LAS int* pend = (LAS int*)(L + LC_PEND);
        if (tid < 32) hist[tid] = 0;
        __syncthreads();
        f32x4 gf[4];
#pragma unroll
        for (int j = 0; j < 4; ++j) gf[j] = ((const GAS f32x4*)g_ffn)[lane + 64 * j];
        const float brt = b_rt[lane & 31], bgr = b_grp[lane & 3];
        const int rows_per_cu = M_TOK / G;
        f32x4 va[4], vb[4];
        { const GAS f32x4* hr = (const GAS f32x4*)(H + (size_t)(vcu * rows_per_cu + 2 * wave) * DM) + lane;
#pragma unroll
          for (int j = 0; j < 4; ++j) { va[j] = hr[64 * j]; vb[j] = hr[256 + 64 * j]; } }
#pragma unroll 1
        for (int rr = 2 * wave; rr < rows_per_cu; rr += 2 * NWAVES) {
            const int m = vcu * rows_per_cu + rr;
            float s2a = 0.f, s2b = 0.f;
#pragma unroll
            for (int j = 0; j < 4; ++j) { s2a += (va[j].x * va[j].x + va[j].y * va[j].y) + (va[j].z * va[j].z + va[j].w * va[j].w); s2b += (vb[j].x * vb[j].x + vb[j].y * vb[j].y) + (vb[j].z * vb[j].z + vb[j].w * vb[j].w); }
            const float rsa = 1.f / sqrtf(wave_sum(s2a) * (1.f / DM) + RMS_EPS), rsb = 1.f / sqrtf(wave_sum(s2b) * (1.f / DM) + RMS_EPS);
#pragma unroll
            for (int j = 0; j < 4; ++j) { va[j] = va[j] * rsa * gf[j]; vb[j] = vb[j] * rsb * gf[j]; }
            { GAS unsigned long long* o8 = (GAS unsigned long long*)(XNd + (size_t)m * DM) + lane;
#pragma unroll
              for (int j = 0; j < 4; ++j) { o8[64 * j] = (unsigned long long)pk2(va[j].x, va[j].y) | ((unsigned long long)pk2(va[j].z, va[j].w) << 32);
                  o8[256 + 64 * j] = (unsigned long long)pk2(vb[j].x, vb[j].y) | ((unsigned long long)pk2(vb[j].z, vb[j].w) << 32); } }
            float pa[36], pb[36];
#pragma unroll
            for (int o = 0; o < 36; ++o) { float a = 0.f, b = 0.f;
#pragma unroll
                for (int j = 0; j < 4; ++j) { const f32x4 w = *(const LAS f32x4*)(wl + o * 1024 + 4 * lane + 256 * j);
                    a += (va[j].x * w.x + va[j].y * w.y) + (va[j].z * w.z + va[j].w * w.w); b += (vb[j].x * w.x + vb[j].y * w.y) + (vb[j].z * w.z + vb[j].w * w.w); }
                pa[o] = a; pb[o] = b; if ((o & 3) == 3) asm volatile("" ::: "memory"); }
            { const int rn = (rr + 2 * NWAVES < rows_per_cu) ? rr + 2 * NWAVES : rr; const GAS f32x4* hr = (const GAS f32x4*)(H + (size_t)(vcu * rows_per_cu + rn) * DM) + lane;
#pragma unroll
              for (int j = 0; j < 4; ++j) { va[j] = hr[64 * j]; vb[j] = hr[256 + 64 * j]; } }
            ROUTE_2ROWS(pa, pb, rr, m);
        }
        __syncthreads();
        if (tid < 32) { const int c = hist[tid]; hbase[tid] = c ? (int)__hip_atomic_fetch_add(GCNTd + tid, (unsigned)c, RLX_AGENT) : 0; }
        __syncthreads();
        if (tid < rows_per_cu * 2) { const int e = pend[tid * 4 + 0], pos = hbase[e] + pend[tid * 4 + 1], m = pend[tid * 4 + 3];
            LISTd[e * M_TOK + pos] = m; WLd[e * M_TOK + pos] = __builtin_bit_cast(float, pend[tid * 4 + 2]);
            TOKd[m * 4 + (tid & 1) * 2 + 0] = e; TOKd[m * 4 + (tid & 1) * 2 + 1] = pos; }
        if (dry) GRID_BAR();
      }
        if (BOTH(4)) GRID_BAR();
    }

    if (IN(5) || IN(6) || IN(7)) {
        LAS int* lcnt = (LAS int*)(L + LC_CNT); LAS int* ltpre = (LAS int*)(L + LC_TPRE); LAS int* lcoff = (LAS int*)(L + LC_COFF); LAS int* tab = (LAS int*)(L + LC_TAB); LAS int* gidx = (LAS int*)(L + LC_GIDX);
        if (tid == 0) { int tp = 0, co = 0; for (int e = 0; e < NEXP; ++e) { const int c = (int)__hip_atomic_load(GCNT + e, RLX_AGENT); lcnt[e] = c; ltpre[e] = tp; lcoff[e] = co; tp += (c + 255) >> 8; co += c; } ltpre[NEXP] = tp; lcoff[NEXP] = co; }
        __syncthreads();
        if (tid < 4) { const int nwg = ltpre[NEXP] * 4; const long Lq = (long)tid * G + bx; int valid = 0, e = 0, mt = 0, pn = 0, rowbase = 0, nvalid = 0;
            if (Lq < nwg) { int wgid = (int)Lq; { const int q = nwg / 8, r = nwg % 8, xcd = wgid % 8, off = wgid / 8; wgid = (xcd < r ? xcd * (q + 1) : r * (q + 1) + (xcd - r) * q) + off; }
                while (e < NEXP - 1 && 4 * ltpre[e + 1] <= wgid) ++e;
                const int Te = ltpre[e + 1] - ltpre[e], loc = wgid - 4 * ltpre[e]; mt = loc % Te; pn = loc / Te; valid = 1;
                rowbase = lcoff[e] + mt * 256; nvalid = lcnt[e] - mt * 256; if (nvalid > 256) nvalid = 256; }
            tab[tid * 8 + 0] = valid; tab[tid * 8 + 1] = e; tab[tid * 8 + 2] = mt; tab[tid * 8 + 3] = pn; tab[tid * 8 + 4] = rowbase; tab[tid * 8 + 5] = nvalid; }
        __syncthreads();
    }
    if (((MK_PHMASK >> 5) & 1) && IN(5)) {
#pragma unroll 1
      for (int rep_ = 0; rep_ < REPS(5); ++rep_) {
        LAS int* tab = (LAS int*)(L + LC_TAB); LAS int* gidx = (LAS int*)(L + LC_GIDX);
        for (int i = tid; i < 3 * 256; i += NWAVES * 64) { const int ui = i >> 8, r = i & 255; int row = 0;
            if (tab[ui * 8 + 0] && r < tab[ui * 8 + 5]) row = LIST[tab[ui * 8 + 1] * M_TOK + tab[ui * 8 + 2] * 256 + r];
            gidx[i] = row; }
        __syncthreads();
        pg8::MoeSched S{tab, (const char*)XN, (const char*)WGU, (size_t)1024 * 1024 * 2, (size_t)256 * 1024 * 2, 2048, true};
        pg8::EpiMoeAct E{(pg8::bf16_t*)ACT, WL};
        pg8::gemm_phase<pg8::EpiMoeAct, pg8::MoeSched, true, true>(L + RING_OFF, 1024, S, E, gidx);
        if (rep_ + 1 < REPS(5)) GRID_BAR();
      }
        if (BOTH(5)) GRID_BAR();
    }
    if (((MK_PHMASK >> 6) & 1) && IN(6)) {
#pragma unroll 1
      for (int rep_ = 0; rep_ < REPS(6); ++rep_) {
        LAS int* tab = (LAS int*)(L + LC_TAB);
        pg8::MoeSched S{tab, (const char*)ACT, (const char*)WDN, (size_t)1024 * 512 * 2, (size_t)256 * 512 * 2, 1024, false};
        pg8::EpiMoeDown E{(pg8::bf16_t*)YP};
        pg8::gemm_phase<pg8::EpiMoeDown, pg8::MoeSched, false, true>(L + RING_OFF, 512, S, E, nullptr);
        if (rep_ + 1 < REPS(6)) GRID_BAR();
      }
        if (BOTH(6)) GRID_BAR();
    }

    if (((MK_PHMASK >> 7) & 1) && IN(7)) {
#pragma unroll 1
      for (int dry = REPS(7) - 1; dry >= 0; --dry) {
        float* Hd = dry ? (float*)(ws + WS_WGU) : H; bf16* XNd = dry ? (bf16*)(ws + WS_WDN) : XN;
        LAS int* lcoff = (LAS int*)(L + LC_COFF);
        f32x4 gp[4];
#pragma unroll
        for (int j = 0; j < 4; ++j) gp[j] = ((const GAS f32x4*)g_ple)[lane + 64 * j];
        typedef int i32x4 __attribute__((ext_vector_type(4)));
        i32x4 tka = *(const GAS i32x4*)(TOKPAIR + (size_t)(2 * gw) * 4), tkb = *(const GAS i32x4*)(TOKPAIR + (size_t)(2 * gw + 1) * 4);
#pragma unroll 1
        for (int m = 2 * gw; m < M_TOK; m += 2 * NGW) {
            const int sa0 = lcoff[tka.x] + tka.y, sa1 = lcoff[tka.z] + tka.w, sb0 = lcoff[tkb.x] + tkb.y, sb1 = lcoff[tkb.z] + tkb.w;
            { const int mn = (m + 2 * NGW < M_TOK) ? m + 2 * NGW : m; tka = *(const GAS i32x4*)(TOKPAIR + (size_t)mn * 4); tkb = *(const GAS i32x4*)(TOKPAIR + (size_t)(mn + 1) * 4); }
            const GAS f32x4* hr = (const GAS f32x4*)(H + (size_t)m * DM) + lane;
            const GAS v2u* ya0 = (const GAS v2u*)(YP + (size_t)sa0 * DM) + lane; const GAS v2u* ya1 = (const GAS v2u*)(YP + (size_t)sa1 * DM) + lane;
            const GAS v2u* yb0 = (const GAS v2u*)(YP + (size_t)sb0 * DM) + lane; const GAS v2u* yb1 = (const GAS v2u*)(YP + (size_t)sb1 * DM) + lane;
            f32x4 va[4], vb[4]; v2u a0[4], a1[4], b0[4], b1[4];
#pragma unroll
            for (int j = 0; j < 4; ++j) { va[j] = hr[64 * j]; vb[j] = hr[256 + 64 * j]; a0[j] = ya0[64 * j]; a1[j] = ya1[64 * j]; b0[j] = yb0[64 * j]; b1[j] = yb1[64 * j]; }
            const f32x4 pva = ((const GAS f32x4*)(p_in + (size_t)m * PLED))[lane], pvb = ((const GAS f32x4*)(p_in + (size_t)(m + 1) * PLED))[lane];
            float s2a = 0.f, s2b = 0.f;
            GAS f32x4* ho = (GAS f32x4*)(Hd + (size_t)m * DM) + lane;
#pragma unroll
            for (int j = 0; j < 4; ++j) {
                va[j].x += bf_lo(a0[j].x) + bf_lo(a1[j].x); va[j].y += bf_hi(a0[j].x) + bf_hi(a1[j].x); va[j].z += bf_lo(a0[j].y) + bf_lo(a1[j].y); va[j].w += bf_hi(a0[j].y) + bf_hi(a1[j].y);
                vb[j].x += bf_lo(b0[j].x) + bf_lo(b1[j].x); vb[j].y += bf_hi(b0[j].x) + bf_hi(b1[j].x); vb[j].z += bf_lo(b0[j].y) + bf_lo(b1[j].y); vb[j].w += bf_hi(b0[j].y) + bf_hi(b1[j].y);
                ho[64 * j] = va[j]; ho[256 + 64 * j] = vb[j];
                s2a += (va[j].x * va[j].x + va[j].y * va[j].y) + (va[j].z * va[j].z + va[j].w * va[j].w); s2b += (vb[j].x * vb[j].x + vb[j].y * vb[j].y) + (vb[j].z * vb[j].z + vb[j].w * vb[j].w); }
            const float rsa = 1.f / sqrtf(wave_sum(s2a) * (1.f / DM) + RMS_EPS), rsb = 1.f / sqrtf(wave_sum(s2b) * (1.f / DM) + RMS_EPS);
            GAS unsigned long long* o8 = (GAS unsigned long long*)(XNd + (size_t)m * DM) + lane;
#pragma unroll
            for (int j = 0; j < 4; ++j) { const f32x4 ta = va[j] * rsa * gp[j], tb = vb[j] * rsb * gp[j];
                o8[64 * j] = (unsigned long long)pk2(ta.x, ta.y) | ((unsigned long long)pk2(ta.z, ta.w) << 32); o8[256 + 64 * j] = (unsigned long long)pk2(tb.x, tb.y) | ((unsigned long long)pk2(tb.z, tb.w) << 32); }
            GAS unsigned long long* po = (GAS unsigned long long*)(PBF + (size_t)m * PLED) + lane;
            po[0] = (unsigned long long)pk2(pva.x, pva.y) | ((unsigned long long)pk2(pva.z, pva.w) << 32); po[64] = (unsigned long long)pk2(pvb.x, pvb.y) | ((unsigned long long)pk2(pvb.z, pvb.w) << 32);
        }
        if (dry) GRID_BAR();
      }
        if (BOTH(7)) GRID_BAR();
    }

    if (((MK_PHMASK >> 8) & 1) && IN(8)) {
#pragma unroll 1
      for (int dry = REPS(8) - 1; dry >= 0; --dry) {
#ifndef MK_NO_P8A
        { pg8::StaticSched S; S.init(PBF, WPP, M_TOK, 1024, 256, G, bx);
          pg8::EpiBf16Plain E{(pg8::bf16_t*)PROJ, 1024};
          pg8::gemm_phase<pg8::EpiBf16Plain, pg8::StaticSched, false, true>(L + RING_OFF, 256, S, E, nullptr); }
#endif
        VM_WAIT();
#ifndef MK_NO_P8B
        { pg8::StaticSched S; S.init(XN, WPG, M_TOK, 1024, 1024, G, bx);
          pg8::EpiPle E{H, dry ? (float*)(ws + WS_WGU) : H, (const pg8::bf16_t*)PROJ};
          pg8::gemm_phase<pg8::EpiPle, pg8::StaticSched, false, true>(L + RING_OFF, 1024, S, E, nullptr); }
#endif
        if (dry) GRID_BAR();
      }
        if (BOTH(8)) GRID_BAR();
    }

    if (((MK_PHMASK >> 9) & 1) && IN(9)) {
#pragma unroll 1
      for (int dry = REPS(9) - 1; dry >= 0; --dry) {
        float* Hd = dry ? (float*)(ws + WS_WGU) : H;
        f32x4 gq[4];
#pragma unroll
        for (int j = 0; j < 4; ++j) gq[j] = ((const GAS f32x4*)g_final)[lane + 64 * j];
#pragma unroll 1
        for (int m = 2 * gw; m < M_TOK; m += 2 * NGW) {
            const GAS f32x4* hr = (const GAS f32x4*)(H + (size_t)m * DM) + lane;
            f32x4 va[4], vb[4]; float s2a = 0.f, s2b = 0.f;
#pragma unroll
            for (int j = 0; j < 4; ++j) { va[j] = hr[64 * j]; vb[j] = hr[256 + 64 * j]; }
#pragma unroll
            for (int j = 0; j < 4; ++j) { s2a += (va[j].x * va[j].x + va[j].y * va[j].y) + (va[j].z * va[j].z + va[j].w * va[j].w); s2b += (vb[j].x * vb[j].x + vb[j].y * vb[j].y) + (vb[j].z * vb[j].z + vb[j].w * vb[j].w); }
            const float rsa = 1.f / sqrtf(wave_sum(s2a) * (1.f / DM) + RMS_EPS), rsb = 1.f / sqrtf(wave_sum(s2b) * (1.f / DM) + RMS_EPS);
            GAS f32x4* ho = (GAS f32x4*)(Hd + (size_t)m * DM) + lane;
#pragma unroll
            for (int j = 0; j < 4; ++j) { ho[64 * j] = va[j] * rsa * gq[j]; ho[256 + 64 * j] = vb[j] * rsb * gq[j]; }
        }
        if (dry) GRID_BAR();
      }
    }
#undef IN
#undef BOTH
#undef GRID_BAR
}
#ifndef MK_HYBRID
#define MK_HYBRID 0
#endif
#ifndef MK_PER_PHASE
#define MK_PER_PHASE 0
#endif
extern "C" void kernel_launch(void* const* d_in, const int* in_sizes, int n_in, void* d_out, int out_size, void* d_ws, size_t ws_size, hipStream_t stream) {
    static int grid = 0;
    if (grid == 0) {
        if (n_in != 20 || in_sizes[0] != M_TOK * DM || out_size != M_TOK * DM || ws_size < WS_END) { fprintf(stderr, "kernel_launch: unexpected shapes / workspace (%d inputs, ws %zu, need %zu); nothing launched\n", n_in, ws_size, (size_t)WS_END); grid = -1; return; }
        int dev = 0, cus = 0, per_cu = 0;
        if (hipGetDevice(&dev) != hipSuccess || hipDeviceGetAttribute(&cus, hipDeviceAttributeMultiprocessorCount, dev) != hipSuccess) { grid = -1; return; }
        if (hipFuncSetAttribute((const void*)mk_fwd, hipFuncAttributeMaxDynamicSharedMemorySize, LDS_BYTES) != hipSuccess) { fprintf(stderr, "kernel_launch: hipFuncSetAttribute(%d B LDS) failed\n", LDS_BYTES); grid = -1; return; }
        if (hipOccupancyMaxActiveBlocksPerMultiprocessor(&per_cu, (const void*)mk_fwd, NWAVES * 64, LDS_BYTES) != hipSuccess || per_cu < 1) { fprintf(stderr, "kernel_launch: occupancy query says %d blocks per CU; nothing launched\n", per_cu); (void)hipGetLastError(); grid = -1; return; }
        grid = cus;
        if (grid != 256) { fprintf(stderr, "kernel_launch: built for 256 CUs, found %d; nothing launched\n", cus); grid = -1; return; }
    }
    if (grid < 0) return;
    (void)hipMemsetAsync((char*)d_ws + WS_CTL, 0, CTL_ZERO_BYTES, stream);
    Args a{};
    for (int i = 0; i < 20; ++i) a.in[i] = (const float*)d_in[i];
    a.out = (float*)d_out; a.ws = (unsigned char*)d_ws;
    const int nmega = MK_HYBRID ? MK_HYBRID : NPHASE;
#if MK_PER_PHASE
    for (int ph = 0; ph < nmega; ++ph) { a.ph_lo = ph; a.ph_hi = ph + 1; a.li = ph; hipLaunchKernelGGL(mk_fwd, dim3(grid), dim3(NWAVES * 64), LDS_BYTES, stream, a); }
#else
    a.ph_lo = 0; a.ph_hi = nmega; a.li = 0;
    hipLaunchKernelGGL(mk_fwd, dim3(grid), dim3(NWAVES * 64), LDS_BYTES, stream, a);
#endif
#if MK_HYBRID
    {
        using namespace v1;
        const float* x = (const float*)d_in[0];      const float* p = (const float*)d_in[1];
        const float* g_ffn = (const float*)d_in[8];  const float* w_grp = (const float*)d_in[9];
        const float* b_grp = (const float*)d_in[10]; const float* w_rt = (const float*)d_in[11];
        const float* b_rt = (const float*)d_in[12];  const float* w_e_gate = (const float*)d_in[13];
        const float* w_e_up = (const float*)d_in[14]; const float* w_e_down = (const float*)d_in[15];
        const float* g_ple = (const float*)d_in[16]; const float* w_ple_gate = (const float*)d_in[17];
        const float* w_ple_proj = (const float*)d_in[18]; const float* g_final = (const float*)d_in[19];
        float* out = (float*)d_out; unsigned char* ws = (unsigned char*)d_ws; (void)x;
        float* Z0 = (float*)ws; float* Z1 = (float*)(ws + 64 * MiB); float* A = (float*)(ws + 136 * MiB); float* Dd = (float*)(ws + 200 * MiB);
        unsigned char* misc = ws + 232 * MiB;
        int* cnt = (int*)(misc + 1 * MiB); int* off = cnt + 64;
        float* lg = (float*)(misc + 1 * MiB + 4096); float* le = lg + NTOK * NG; int* tokpair = (int*)(le + NTOK * NE);
        int* list = (int*)(misc + 4 * MiB); float* wl = (float*)(misc + 6 * MiB);
        if (MK_HYBRID <= 4) {
            (void)hipMemsetAsync(cnt, 0, 512, stream);
            hipLaunchKernelGGL(rmsnorm_k, dim3(NTOK), dim3(256), 0, stream, out, g_ffn, A);
            sgemm(stream, A, D_MODEL, w_grp, NG, lg, NG, NTOK, NG, D_MODEL);
            sgemm(stream, A, D_MODEL, w_rt, NE, le, NE, NTOK, NE, D_MODEL);
            hipLaunchKernelGGL(router_select_k, dim3(NTOK / 256), dim3(256), 0, stream, lg, le, b_grp, b_rt, cnt, list, wl, tokpair);
            hipLaunchKernelGGL(offsets_k, dim3(1), dim3(64), 0, stream, cnt, off);
            float* Hg = Z0; float* Hu = Z1; float* Y = Z1;
            sgemm(stream, A, D_MODEL, w_e_gate, DEXP, Hg, DEXP, NTOK, DEXP, D_MODEL, nullptr, nullptr, 0, cnt, off, list, NTOK, (size_t)D_MODEL * DEXP, NE);
            sgemm(stream, A, D_MODEL, w_e_up, DEXP, Hu, DEXP, NTOK, DEXP, D_MODEL, nullptr, nullptr, 0, cnt, off, list, NTOK, (size_t)D_MODEL * DEXP, NE);
            hipLaunchKernelGGL(moe_act_k, dim3(NTOK * DEXP / 256, NE), dim3(256), 0, stream, Hg, Hu, cnt, off, wl);
            int* slotlist = (int*)Dd;
            hipLaunchKernelGGL(slotlist_k, dim3(NTOK / 256, NE), dim3(256), 0, stream, cnt, off, slotlist);
            sgemm(stream, Hg, DEXP, w_e_down, D_MODEL, Y, D_MODEL, NTOK, D_MODEL, DEXP, nullptr, nullptr, 0, cnt, off, slotlist, NTOK, (size_t)DEXP * D_MODEL, NE);
            hipLaunchKernelGGL(moe_combine_k, dim3(NTOK * D_MODEL / 256), dim3(256), 0, stream, out, Y, off, tokpair);
        }
        if (MK_HYBRID <= 8) {
            hipLaunchKernelGGL(rmsnorm_k, dim3(NTOK), dim3(256), 0, stream, out, g_ple, Z0);
            float* Gt = Z1; float* Pj = Z1 + (size_t)NTOK * D_MODEL;
            sgemm(stream, Z0, D_MODEL, w_ple_gate, D_MODEL, Gt, D_MODEL, NTOK, D_MODEL, D_MODEL);
            sgemm(stream, p, PLE_DIM, w_ple_proj, D_MODEL, Pj, D_MODEL, NTOK, D_MODEL, PLE_DIM);
            hipLaunchKernelGGL(ple_combine_k, dim3(NTOK * D_MODEL / 256), dim3(256), 0, stream, out, Gt, Pj);
        }
        hipLaunchKernelGGL(rmsnorm_k, dim3(NTOK), dim3(256), 0, stream, out, g_final, out);
    }
#endif
}
```

```cpp
#include <hip/hip_runtime.h>
#include <hip/hip_bf16.h>
#include <cstdio>
#include <cstdint>
namespace pg8 {
#define PG8_LAS __attribute__((address_space(3)))
typedef unsigned short bf16_t;
typedef short bf16x8 __attribute__((ext_vector_type(8)));
typedef float f32x4 __attribute__((ext_vector_type(4)));
typedef unsigned u32x4 __attribute__((ext_vector_type(4)));
typedef unsigned u32x2 __attribute__((ext_vector_type(2)));
constexpr int BM = 256, BK = 64, HALF = 128, HTB = HALF * BK * 2  , STAGE_BYTES = 8 * HTB, NXCD = 8, WGM = 8;

__host__ __device__ __forceinline__ int lds_byte(int r, int c) { const int st = (r >> 4) * 2 + (c >> 5), rr = r & 15, cc = c & 31, ob = rr * 64 + cc * 2; return st * 1024 + (ob ^ (((ob >> 9) & 1) << 5)); }
__host__ __device__ __forceinline__ void stage_rc(int b, int& R, int& C) { const int st = b / 1024, sb = b % 1024, swz = sb ^ (((sb >> 9) & 1) << 5); R = (st >> 1) * 16 + swz / 64; C = (st & 1) * 32 + (swz % 64) / 2; }
__host__ __device__ __forceinline__ int perm32(int rho) { const int n = rho >> 4, i = rho & 15; return 8 * (i >> 2) + 4 * n + (i & 3); }

struct Unit { int pm, pn; const char* a; const char* b; int x0, x1, x2, x3; };

__device__ __forceinline__ unsigned cvt_pk_bf16(float lo, float hi) { unsigned r; asm volatile("v_cvt_pk_bf16_f32 %0, %1, %2" : "=v"(r) : "v"(lo), "v"(hi)); return r; }

struct StaticSched {
    const char* A; const char* Bt; size_t tstep; int nM, nN, nwg, G, c;
    __device__ __forceinline__ void init(const void* A_, const void* Bt_, int M, int N, int K, int G_, int c_) { A = (const char*)A_; Bt = (const char*)Bt_; tstep = (size_t)BM * K * 2; nM = M / BM; nN = N / BM; nwg = nM * nN; G = G_; c = c_; }
    __device__ __forceinline__ bool next(int i, Unit& u) const {
        const long L = (long)i * G + c; if (L >= nwg) return false;
        int wgid = (int)L; { const int q = nwg / NXCD, r = nwg % NXCD, xcd = wgid % NXCD, off = wgid / NXCD; wgid = (xcd < r ? xcd * (q + 1) : r * (q + 1) + (xcd - r) * q) + off; }
        const int nig = WGM * nN, gid = wgid / nig, fm = gid * WGM, gsz = (nM - fm) < WGM ? (nM - fm) : WGM;
        u.pm = fm + ((wgid % nig) % gsz); u.pn = (wgid % nig) / gsz; u.a = A + (size_t)u.pm * tstep; u.b = Bt + (size_t)u.pn * tstep; u.x0 = u.x1 = u.x2 = u.x3 = 0; return true;
    }
};

template <class Epi, class Sched, bool GATHER, bool ALIGN_EPI>
__device__ __forceinline__ void gemm_phase(PG8_LAS unsigned char* lds, const int K, const Sched& S, const Epi& E, const PG8_LAS int* gidx) {
    const int tid = threadIdx.x, wid = __builtin_amdgcn_readfirstlane(tid >> 6), lane = tid & 63, wr = wid >> 2, wc = wid & 3, fr = lane & 15, fq = lane >> 4;
    const int nt = K / BK;
    unsigned voffB[2], vAc0[2], vAc1[2], vAn0[2], vAn1[2]; int Rr[2], Cc[2];
#pragma unroll
    for (int i = 0; i < 2; ++i) { int R, C; stage_rc(tid * 16 + i * 8192, R, C); const int Rb = Epi::PERM ? ((R & ~31) + perm32(R & 31)) : R; Rr[i] = R; Cc[i] = C; voffB[i] = (unsigned)(Rb * K + C) * 2u; }
#define PG8_SETA(v0, v1, ui_) do { _Pragma("unroll") for (int _i = 0; _i < 2; ++_i) { \
        const int r0_ = GATHER ? gidx[(ui_) * 256 + Rr[_i]] : Rr[_i]; const int r1_ = GATHER ? gidx[(ui_) * 256 + HALF + Rr[_i]] : (HALF + Rr[_i]); \
        v0[_i] = (unsigned)(r0_ * K + Cc[_i]) * 2u; v1[_i] = (unsigned)(r1_ * K + Cc[_i]) * 2u; } } while (0)
    const size_t kstep = (size_t)(BK * 2);
    const size_t hstep = (size_t)HALF * K * 2;
    const unsigned ldsw = (unsigned)wid * 1024u;
    const int aoff = lds_byte(wr * 64 + fr, fq * 8), boff = lds_byte(wc * 32 + fr, fq * 8);
#define PG8_SA(b, h) (((b) * 2 + (h)) * HTB)
#define PG8_SB(b, h) ((4 + (b) * 2 + (h)) * HTB)
#define PG8_STAGE(bufoff, gbase, voff) do { _Pragma("unroll") for (int _i = 0; _i < 2; ++_i) \
        __builtin_amdgcn_global_load_lds((const unsigned*)((const char*)(gbase) + (voff)[_i]), (PG8_LAS unsigned*)(lds + (bufoff) + ldsw + _i * 8192), 16, 0, 0); } while (0)
#define PG8_LDA(dst, b, h) do { _Pragma("unroll") for (int m = 0; m < 4; ++m) _Pragma("unroll") for (int k = 0; k < 2; ++k) dst[m][k] = *(const PG8_LAS bf16x8*)(lds + PG8_SA(b, h) + aoff + m * 2048 + k * 1024); } while (0)
#define PG8_LDB(dst, b, h) do { _Pragma("unroll") for (int n = 0; n < 2; ++n) _Pragma("unroll") for (int k = 0; k < 2; ++k) dst[n][k] = *(const PG8_LAS bf16x8*)(lds + PG8_SB(b, h) + boff + n * 2048 + k * 1024); } while (0)
#define PG8_MMA(ai, bj, At, Bt) do { __builtin_amdgcn_s_setprio(1); _Pragma("unroll") for (int m = 0; m < 4; ++m) _Pragma("unroll") for (int n = 0; n < 2; ++n) _Pragma("unroll") for (int k = 0; k < 2; ++k) \
        acc[ai][bj][m][n] = __builtin_amdgcn_mfma_f32_16x16x32_bf16(Bt[n][k], At[m][k], acc[ai][bj][m][n], 0, 0, 0); __builtin_amdgcn_s_setprio(0); } while (0)
#define PG8_WAIT_V(n) asm volatile("s_waitcnt vmcnt(" #n ")" ::: "memory")
#define PG8_WAIT_L(n) asm volatile("s_waitcnt lgkmcnt(" #n ")" ::: "memory")
#define PG8_BAR __builtin_amdgcn_s_barrier()
#define PG8_SCHED __builtin_amdgcn_sched_barrier(0)
    Unit cur, nxt; int ui = 0;
    if (!S.next(0, cur)) return;
    f32x4 acc[2][2][4][2];
#pragma unroll
    for (int a = 0; a < 2; ++a)
#pragma unroll
        for (int b = 0; b < 2; ++b)
#pragma unroll
            for (int m = 0; m < 4; ++m)
#pragma unroll
                for (int n = 0; n < 2; ++n) acc[a][b][m][n] = (f32x4){0.f, 0.f, 0.f, 0.f};
    bf16x8 At[4][2], B0[2][2], B1[2][2];
    const char* cA = cur.a; const char* cB = cur.b;
    PG8_SETA(vAc0, vAc1, 0);
    PG8_STAGE(PG8_SB(0, 0), cB, voffB); PG8_STAGE(PG8_SB(0, 1), cB + hstep, voffB); PG8_STAGE(PG8_SA(0, 0), cA, vAc0); PG8_STAGE(PG8_SA(0, 1), cA, vAc1);
    if (wr == 1) PG8_BAR;
    PG8_WAIT_V(2); PG8_BAR;
    PG8_STAGE(PG8_SB(1, 0), cB + kstep, voffB); PG8_STAGE(PG8_SA(1, 0), cA + kstep, vAc0); PG8_STAGE(PG8_SB(1, 1), cB + hstep + kstep, voffB);
    PG8_WAIT_V(6); PG8_BAR;
    for (;;) {
        const bool has_next = S.next(ui + 1, nxt);
        const char* nA = has_next ? nxt.a : cA; const char* nB = has_next ? nxt.b : cB;
        if (has_next) { PG8_SETA(vAn0, vAn1, ui + 1); } else { vAn0[0] = vAc0[0]; vAn0[1] = vAc0[1]; vAn1[0] = vAc1[0]; vAn1[1] = vAc1[1]; }
#pragma unroll 1
        for (int t = 0; t < nt; t += 2) {
            const bool last = (t == nt - 2);
            const char* a1 = cA + (size_t)(t + 1) * kstep;
            const char* a2 = last ? nA : cA + (size_t)(t + 2) * kstep; const char* b2 = last ? nB : cB + (size_t)(t + 2) * kstep;
            const char* a3 = a2 + kstep; const char* b3 = b2 + kstep;
            unsigned v20[2], v21[2];
            v20[0] = last ? vAn0[0] : vAc0[0]; v20[1] = last ? vAn0[1] : vAc0[1]; v21[0] = last ? vAn1[0] : vAc1[0]; v21[1] = last ? vAn1[1] : vAc1[1];
            PG8_LDB(B0, 0, 0); PG8_LDB(B1, 0, 1); PG8_SCHED; PG8_LDA(At, 0, 0); PG8_STAGE(PG8_SA(1, 1), a1, vAc1);
            PG8_WAIT_V(8); PG8_WAIT_L(0); PG8_BAR; PG8_MMA(0, 0, At, B0); PG8_MMA(0, 1, At, B1); PG8_BAR; PG8_SCHED;
            PG8_LDA(At, 0, 1); PG8_STAGE(PG8_SB(0, 0), b2, voffB); PG8_STAGE(PG8_SB(0, 1), b2 + hstep, voffB); PG8_STAGE(PG8_SA(0, 0), a2, v20);
            PG8_WAIT_V(8); PG8_WAIT_L(0); PG8_BAR; PG8_MMA(1, 0, At, B0); PG8_MMA(1, 1, At, B1); PG8_BAR; PG8_SCHED;
            PG8_LDB(B0, 1, 0); PG8_LDB(B1, 1, 1); PG8_SCHED; PG8_LDA(At, 1, 0); PG8_STAGE(PG8_SA(0, 1), a2, v21);
            PG8_WAIT_V(8); PG8_WAIT_L(0); PG8_BAR; PG8_MMA(0, 0, At, B0); PG8_MMA(0, 1, At, B1); PG8_BAR; PG8_SCHED;
            PG8_LDA(At, 1, 1); PG8_STAGE(PG8_SB(1, 0), b3, voffB); PG8_STAGE(PG8_SB(1, 1), b3 + hstep, voffB); PG8_STAGE(PG8_SA(1, 0), a3, v20);
            PG8_WAIT_V(8); PG8_WAIT_L(0); PG8_BAR; PG8_MMA(1, 0, At, B0); PG8_MMA(1, 1, At, B1); PG8_BAR; PG8_SCHED;
        }
        if constexpr (ALIGN_EPI) { if (wr == 0) PG8_BAR; }
        E(acc, cur, wr, wc, fr, fq);
        if (!has_next) break;
#pragma unroll
        for (int a = 0; a < 2; ++a)
#pragma unroll
            for (int b = 0; b < 2; ++b)
#pragma unroll
                for (int m = 0; m < 4; ++m)
#pragma unroll
                    for (int n = 0; n < 2; ++n) acc[a][b][m][n] = (f32x4){0.f, 0.f, 0.f, 0.f};
        cur = nxt; cA = nA; cB = nB; ++ui;
        vAc0[0] = vAn0[0]; vAc0[1] = vAn0[1]; vAc1[0] = vAn1[0]; vAc1[1] = vAn1[1];
        if constexpr (ALIGN_EPI) { if (wr == 1) PG8_BAR; }
    }
    PG8_WAIT_V(0);
    if constexpr (!ALIGN_EPI) { if (wr == 0) PG8_BAR; }
    PG8_BAR;
#undef PG8_SETA
#undef PG8_SA
#undef PG8_SB
#undef PG8_STAGE
#undef PG8_LDA
#undef PG8_LDB
#undef PG8_MMA
#undef PG8_WAIT_V
#undef PG8_WAIT_L
#undef PG8_BAR
#undef PG8_SCHED
}
}
namespace fox {
using bf16 = __hip_bfloat16;
using bf16x8 = __attribute__((ext_vector_type(8))) short;
using s16x4 = __attribute__((ext_vector_type(4))) short;
using f32x16 = __attribute__((ext_vector_type(16))) float;
using u32x4 = __attribute__((ext_vector_type(4))) unsigned;
typedef float f32x4v __attribute__((ext_vector_type(4)));
constexpr int SEQ = 2048, D = 64, PITCH = 512, OPITCH = 1024, NHEAD = 8;
constexpr int NW = 8, QBLK = 32, QB = QBLK * NW, KVBLK = 64, NQB = SEQ / QB;
constexpr int SLOTB = 8192, LDS_K = 0, LDS_V = 2 * SLOTB, LDS_C = 4 * SLOTB, LDS_WS = LDS_C + SEQ * 4, LDS_OST = LDS_WS + NW * 64 * 4, LDS_BYTES = LDS_OST + NW * 4096;
constexpr float C2 = 0.125f * 1.4426950408889634f;
__device__ __forceinline__ int crow(int r, int hi) { return (r & 3) + 8 * (r >> 2) + 4 * hi; }
#define FOX_SBAR() __builtin_amdgcn_sched_barrier(0)
__device__ __forceinline__ void cmask(f32x16& p0, f32x16& p1, int jb, int qrel, int hi) {
    const float NEG = -INFINITY; int kb = 64 * jb + 4 * hi;
#pragma unroll
    for (int r = 0; r < 16; ++r) { int kv = kb + (r & 3) + 8 * (r >> 2); if (kv > qrel) p0[r] = NEG; if (kv + 32 > qrel) p1[r] = NEG; }
}
__device__ __forceinline__ void glds16(const void* gsrc, unsigned lds_dst) { unsigned keep;
    asm volatile("s_mov_b32 %0, m0\n\ts_mov_b32 m0, %2\n\ts_nop 0\n\tglobal_load_lds_dwordx4 %1, off\n\ts_mov_b32 m0, %0" : "=&s"(keep) : "v"(gsrc), "s"(lds_dst) : "memory"); }
typedef float f32x2_t __attribute__((ext_vector_type(2))); typedef __bf16 bf16x2_t __attribute__((ext_vector_type(2)));
__device__ __forceinline__ unsigned cvtpk_s(float lo, float hi) { f32x2_t v = {lo, hi}; bf16x2_t b = __builtin_convertvector(v, bf16x2_t); return __builtin_bit_cast(unsigned, b); }
typedef __attribute__((address_space(3))) const char* lds_cptr;
__device__ __forceinline__ float rowmax(const f32x16& p0, const f32x16& p1) {
    float a = fmaxf(p0[0], p1[0]);
#pragma unroll
    for (int r = 1; r < 16; ++r) a = fmaxf(a, fmaxf(p0[r], p1[r]));
    return fmaxf(a, __shfl_xor(a, 32));
}
__device__ __forceinline__ void pv(f32x16* o, int vb, bf16x8 pa0, bf16x8 pa1, bf16x8 pa2, bf16x8 pa3) {
#pragma unroll
    for (int d0 = 0; d0 < 2; ++d0) { s16x4 lo[4], hi[4];
#pragma unroll
        for (int ks = 0; ks < 4; ++ks) {
            asm volatile("ds_read_b64_tr_b16 %0,%1 offset:%c2" : "=&v"(lo[ks]) : "v"(vb), "i"(d0 * 4096 + ks * 1024) : "memory");
            asm volatile("ds_read_b64_tr_b16 %0,%1 offset:%c2" : "=&v"(hi[ks]) : "v"(vb), "i"(d0 * 4096 + ks * 1024 + 512) : "memory"); }
        asm volatile("s_waitcnt lgkmcnt(0)" ::: "memory"); FOX_SBAR();
#define FOX_PK(k) (bf16x8){lo[k][0], lo[k][1], lo[k][2], lo[k][3], hi[k][0], hi[k][1], hi[k][2], hi[k][3]}
        o[d0] = __builtin_amdgcn_mfma_f32_32x32x16_bf16(pa0, FOX_PK(0), o[d0], 0, 0, 0);
        o[d0] = __builtin_amdgcn_mfma_f32_32x32x16_bf16(pa1, FOX_PK(1), o[d0], 0, 0, 0);
        o[d0] = __builtin_amdgcn_mfma_f32_32x32x16_bf16(pa2, FOX_PK(2), o[d0], 0, 0, 0);
        o[d0] = __builtin_amdgcn_mfma_f32_32x32x16_bf16(pa3, FOX_PK(3), o[d0], 0, 0, 0);
#undef FOX_PK
    }
}
#define FOX_WAIT_BAR(N) asm volatile("s_waitcnt vmcnt(" #N ") lgkmcnt(0)\n\ts_barrier" ::: "memory")

__device__ __forceinline__ void attn_unit(int b, int h, int qb, const bf16* Q, const bf16* __restrict__ K, const bf16* __restrict__ V, const float* __restrict__ c2g, bf16* O, int ocol0, char* shm) {
    const int tid = threadIdx.x, lane = tid & 63, r32 = lane & 31, hi = lane >> 5; const int wid = __builtin_amdgcn_readfirstlane(tid >> 6);
    const long rowbase = (long)b * SEQ; const int q0 = qb * QB;
    const bf16* Qw = Q + (rowbase + q0 + wid * QBLK) * PITCH + h * D;
    const bf16* Kh = K + rowbase * PITCH + h * D, *Vh = V + rowbase * PITCH + h * D;
    const unsigned lds0 = (unsigned)(uintptr_t)shm;
    float* wsf = (float*)(shm + LDS_WS) + wid * 64;
    float* cs = (float*)(shm + LDS_C);
    const bf16* ksrc = Kh + (long)lane * PITCH + wid * 8;
    const bf16* vsrc = Vh + (long)(16 * (wid & 3) + (lane >> 2)) * PITCH + (wid >> 2) * 32 + (lane & 3) * 8;
    const unsigned kdst = lds0 + LDS_K + wid * 1024, vdst = lds0 + LDS_V + wid * 1024;
#define FOX_DMA_K(t, slot) glds16(ksrc + (long)(t) * KVBLK * PITCH, (unsigned)__builtin_amdgcn_readfirstlane(kdst + (slot)))
#define FOX_DMA_V(t, slot) glds16(vsrc + (long)(t) * KVBLK * PITCH, (unsigned)__builtin_amdgcn_readfirstlane(vdst + (slot)))
    const int vb0 = (int)(lds0 + LDS_V) + ((lane >> 4) & 1) * 32 + (lane & 3) * 8 + (4 * hi + ((lane & 15) >> 2)) * 64;
    const lds_cptr kp0 = (lds_cptr)shm + LDS_K + hi * 1024 + r32 * 16;
    const int NT = (q0 + QB) / KVBLK;
    FOX_DMA_K(0, 0); FOX_DMA_V(0, 0);
    { const float* cg = c2g + (size_t)(b * NHEAD + h) * SEQ; for (int i = tid; i < q0 + QB; i += NW * 64) cs[i] = cg[i]; }
    bf16x8 qr[4];
#pragma unroll
    for (int d0 = 0; d0 < 4; ++d0) qr[d0] = *reinterpret_cast<const bf16x8*>(&Qw[(long)r32 * PITCH + d0 * 16 + hi * 8]);
    FOX_WAIT_BAR(0);
    const int qrel = wid * QBLK + r32;
    const float cq = cs[q0 + qrel];
    float m_run = -INFINITY, l_reg = 0.f; f32x16 o[2]; o[0] = f32x16{}; o[1] = f32x16{};
    for (int t = 0; t < NT; ++t) {
        const int slot = (t & 1) * SLOTB;
        if (t + 1 < NT) { FOX_DMA_K(t + 1, slot ^ SLOTB); FOX_DMA_V(t + 1, slot ^ SLOTB); FOX_WAIT_BAR(2); } else { FOX_WAIT_BAR(0); }
        f32x16 p0, p1;
#pragma unroll
        for (int g = 0; g < 4; ++g) { const f32x4v ca = *(const f32x4v*)(cs + t * KVBLK + 8 * g + 4 * hi), cb = *(const f32x4v*)(cs + t * KVBLK + 32 + 8 * g + 4 * hi);
#pragma unroll
            for (int j = 0; j < 4; ++j) { p0[4 * g + j] = cq - ca[j]; p1[4 * g + j] = cq - cb[j]; } }
        { const lds_cptr kb = kp0 + slot;
#pragma unroll
          for (int d0 = 0; d0 < 4; ++d0) {
              const bf16x8 b0 = *(const __attribute__((address_space(3))) bf16x8*)(kb + d0 * 2048);
              const bf16x8 b1 = *(const __attribute__((address_space(3))) bf16x8*)(kb + d0 * 2048 + 512);
              p0 = __builtin_amdgcn_mfma_f32_32x32x16_bf16(b0, qr[d0], p0, 0, 0, 0); p1 = __builtin_amdgcn_mfma_f32_32x32x16_bf16(b1, qr[d0], p1, 0, 0, 0); } }
        { const int jb = t - (NT - 4); if (jb >= 0) cmask(p0, p1, jb, qrel, hi); }
        const float rm = rowmax(p0, p1);
        const float m_new = fmaxf(m_run, rm);
        const float alpha = __builtin_amdgcn_exp2f(m_run - m_new);
        m_run = m_new;
        float sacc = 0.f;
#pragma unroll
        for (int r = 0; r < 16; ++r) { p0[r] = __builtin_amdgcn_exp2f(p0[r] - m_new); p1[r] = __builtin_amdgcn_exp2f(p1[r] - m_new); sacc += p0[r] + p1[r]; }
        l_reg = l_reg * alpha + sacc;
        if (hi == 0) wsf[r32] = alpha;
        asm volatile("s_waitcnt lgkmcnt(0)" ::: "memory");
#pragma unroll
        for (int d_ = 0; d_ < 2; ++d_)
#pragma unroll
            for (int r = 0; r < 16; ++r) o[d_][r] *= wsf[crow(r, hi)];
        u32x4 pw0, pw1, pw2, pw3;
#define FOX_PKW(P, B) cvtpk_s(P[B], P[B + 1])
        pw0 = (u32x4){FOX_PKW(p0, 0), FOX_PKW(p0, 2), FOX_PKW(p0, 4), FOX_PKW(p0, 6)}; pw1 = (u32x4){FOX_PKW(p0, 8), FOX_PKW(p0, 10), FOX_PKW(p0, 12), FOX_PKW(p0, 14)};
        pw2 = (u32x4){FOX_PKW(p1, 0), FOX_PKW(p1, 2), FOX_PKW(p1, 4), FOX_PKW(p1, 6)}; pw3 = (u32x4){FOX_PKW(p1, 8), FOX_PKW(p1, 10), FOX_PKW(p1, 12), FOX_PKW(p1, 14)};
#undef FOX_PKW
        FOX_SBAR();
        pv(o, vb0 + slot, __builtin_bit_cast(bf16x8, pw0), __builtin_bit_cast(bf16x8, pw1), __builtin_bit_cast(bf16x8, pw2), __builtin_bit_cast(bf16x8, pw3));
        asm volatile("s_waitcnt lgkmcnt(0)\n\ts_barrier" ::: "memory");
    }
    l_reg += __shfl_xor(l_reg, 32);
    if (hi == 0) wsf[32 + r32] = l_reg; asm volatile("s_waitcnt lgkmcnt(0)" ::: "memory");
    float rli[16];
#pragma unroll
    for (int r = 0; r < 16; ++r) rli[r] = 1.0f / wsf[32 + crow(r, hi)];
    bf16* Ow = O + (rowbase + q0 + wid * QBLK) * OPITCH + ocol0 + h * D;
    { bf16* stg = (bf16*)(shm + LDS_OST) + wid * 2048;
#pragma unroll
      for (int r = 0; r < 16; ++r) { const int orow = crow(r, hi);
#pragma unroll
          for (int d0 = 0; d0 < 2; ++d0) stg[orow * 64 + d0 * 32 + r32] = __float2bfloat16(o[d0][r] * rli[r]); }
      asm volatile("s_waitcnt lgkmcnt(0)" ::: "memory");
#pragma unroll
      for (int i = 0; i < 4; ++i) { const int row = i * 8 + (lane >> 3), ch = lane & 7; const u32x4 v = *(const u32x4*)(stg + row * 64 + ch * 8); *(u32x4*)(Ow + (long)row * OPITCH + ch * 8) = v; } }
    asm volatile("s_waitcnt vmcnt(0) lgkmcnt(0)\n\ts_barrier" ::: "memory");
#undef FOX_DMA_K
#undef FOX_DMA_V
}
#undef FOX_SBAR
#undef FOX_WAIT_BAR
}
namespace fox2 {
using bf16=__hip_bfloat16;
using bf16x8=__attribute__((ext_vector_type(8)))short;
using s16x4=__attribute__((ext_vector_type(4)))short;
using f32x16=__attribute__((ext_vector_type(16)))float;
using u32x4=__attribute__((ext_vector_type(4)))unsigned;
constexpr int BATCH=8,NHEAD=8,SEQ=2048,D=64,DM=512,OPITCH=1024;
typedef float f32x4v __attribute__((ext_vector_type(4)));
constexpr int NW=8,QBLK=32,QB=QBLK*NW,KVBLK=64,NQB=SEQ/QB;
__device__ __forceinline__ int crow(int r,int hi){return (r&3)+8*(r>>2)+4*hi;}
#define SBAR() __builtin_amdgcn_sched_barrier(0)
__device__ __forceinline__ void cmask(f32x16&p0,f32x16&p1,int jb,int qrel,int hi){
  const float NEG=-INFINITY; int kb=64*jb+4*hi;
  #pragma unroll
  for(int r=0;r<16;++r){int kv=kb+(r&3)+8*(r>>2); if(kv>qrel)p0[r]=NEG; if(kv+32>qrel)p1[r]=NEG;}
}

constexpr int NSLOT=3, SLOTB=8192;
constexpr int LDS_K=0, LDS_V=NSLOT*SLOTB, LDS_WS=2*NSLOT*SLOTB, LDS_OST=LDS_WS+NW*64*4, LDS_C=LDS_OST+NW*4096, LDS_BYTES=LDS_C+SEQ*4;
constexpr float C2=0.125f*1.4426950408889634f;
__device__ __forceinline__ void glds16(const void*gsrc,unsigned lds_dst){unsigned keep;
  asm volatile("s_mov_b32 %0, m0\n\ts_mov_b32 m0, %2\n\ts_nop 0\n\tglobal_load_lds_dwordx4 %1, off\n\ts_mov_b32 m0, %0":"=&s"(keep):"v"(gsrc),"s"(lds_dst):"memory");}
__device__ __forceinline__ float max3f(float a,float b,float c){float r;asm("v_max3_f32 %0, %1, %2, %3":"=v"(r):"v"(a),"v"(b),"v"(c));return r;}
__device__ __forceinline__ float max2f(float a,float b){float r;asm("v_max_f32_e32 %0, %1, %2":"=v"(r):"v"(a),"v"(b));return r;}
__device__ __forceinline__ float fadd_s(float a,float b){float r;asm("v_add_f32_e32 %0, %1, %2":"=v"(r):"v"(a),"v"(b));return r;}
__device__ __forceinline__ float fsub_s(float a,float b){float r;asm("v_sub_f32_e32 %0, %1, %2":"=v"(r):"v"(a),"v"(b));return r;}
typedef float f32x2_t __attribute__((ext_vector_type(2))); typedef __bf16 bf16x2_t __attribute__((ext_vector_type(2)));
__device__ __forceinline__ unsigned cvtpk_s(float lo,float hi){f32x2_t v={lo,hi};bf16x2_t b=__builtin_convertvector(v,bf16x2_t);return __builtin_bit_cast(unsigned,b);}
#define WAIT_BAR(N) asm volatile("s_waitcnt vmcnt(" #N ") lgkmcnt(0)\n\ts_barrier":::"memory")

__device__ __forceinline__ void qkt(f32x16&p0,f32x16&p1,const char*Kslot,const bf16x8*qr,int r32,int hi){
  const char*kb=Kslot+hi*1024+r32*16;
  #pragma unroll
  for(int d0=0;d0<4;++d0){
    const bf16x8 b0=*reinterpret_cast<const bf16x8*>(kb+d0*2048);
    const bf16x8 b1=*reinterpret_cast<const bf16x8*>(kb+d0*2048+512);
    p0=__builtin_amdgcn_mfma_f32_32x32x16_bf16(b0,qr[d0],p0,0,0,0);p1=__builtin_amdgcn_mfma_f32_32x32x16_bf16(b1,qr[d0],p1,0,0,0);}
}
typedef __attribute__((address_space(3))) const char* lds_cptr;
typedef short v4i16_t __attribute__((ext_vector_type(4)));
__device__ __forceinline__ void kload8(bf16x8*kf,lds_cptr kp){
  kf[0]=*(const __attribute__((address_space(3))) bf16x8*)(kp);      kf[1]=*(const __attribute__((address_space(3))) bf16x8*)(kp+512);
  kf[2]=*(const __attribute__((address_space(3))) bf16x8*)(kp+2048); kf[3]=*(const __attribute__((address_space(3))) bf16x8*)(kp+2560);
  kf[4]=*(const __attribute__((address_space(3))) bf16x8*)(kp+4096); kf[5]=*(const __attribute__((address_space(3))) bf16x8*)(kp+4608);
  kf[6]=*(const __attribute__((address_space(3))) bf16x8*)(kp+6144); kf[7]=*(const __attribute__((address_space(3))) bf16x8*)(kp+6656);
}
__device__ __forceinline__ void kload2(bf16x8*kf,lds_cptr kp,int j){ kf[2*j]=*(const __attribute__((address_space(3))) bf16x8*)(kp+j*2048); kf[2*j+1]=*(const __attribute__((address_space(3))) bf16x8*)(kp+j*2048+512); }
__device__ __forceinline__ s16x4 vtr(lds_cptr p){ return __builtin_bit_cast(s16x4,__builtin_amdgcn_ds_read_tr16_b64_v4i16((__attribute__((address_space(3))) v4i16_t*)p)); }
__device__ __forceinline__ float rowmax(const f32x16&p0,const f32x16&p1){
  float a=max3f(p0[0],p0[1],p1[0]),b=max3f(p0[2],p0[3],p1[1]);a=max3f(a,p1[2],p1[3]);
  #pragma unroll
  for(int r=4;r<16;r+=4){a=max3f(a,p0[r],p0[r+1]);b=max3f(b,p0[r+2],p0[r+3]);a=max3f(a,p1[r],p1[r+1]);b=max3f(b,p1[r+2],p1[r+3]);}
  const float m=max2f(a,b);
  auto rr=__builtin_amdgcn_permlane32_swap(__float_as_uint(m),__float_as_uint(m),false,false);
  return max2f(__uint_as_float(rr[0]),__uint_as_float(rr[1]));
}
__device__ __forceinline__ void pv(f32x16*o,int vb,bf16x8 pa0,bf16x8 pa1,bf16x8 pa2,bf16x8 pa3){
  #pragma unroll
  for(int d0=0;d0<2;++d0){s16x4 lo[4],hi[4];
    #pragma unroll
    for(int ks=0;ks<4;++ks){
      asm volatile("ds_read_b64_tr_b16 %0,%1 offset:%c2":"=&v"(lo[ks]):"v"(vb),"i"(d0*4096+ks*1024):"memory");
      asm volatile("ds_read_b64_tr_b16 %0,%1 offset:%c2":"=&v"(hi[ks]):"v"(vb),"i"(d0*4096+ks*1024+512):"memory");}
    asm volatile("s_waitcnt lgkmcnt(0)":::"memory");SBAR();
    #define PK(k) (bf16x8){lo[k][0],lo[k][1],lo[k][2],lo[k][3],hi[k][0],hi[k][1],hi[k][2],hi[k][3]}
    o[d0]=__builtin_amdgcn_mfma_f32_32x32x16_bf16(pa0,PK(0),o[d0],0,0,0);
    o[d0]=__builtin_amdgcn_mfma_f32_32x32x16_bf16(pa1,PK(1),o[d0],0,0,0);
    o[d0]=__builtin_amdgcn_mfma_f32_32x32x16_bf16(pa2,PK(2),o[d0],0,0,0);
    o[d0]=__builtin_amdgcn_mfma_f32_32x32x16_bf16(pa3,PK(3),o[d0],0,0,0);
    #undef PK
  }
}

#ifndef ATTN_STORE16
#define ATTN_STORE16(p,v) (*(u32x4*)(p)=(v))
#endif
template<int THRL> __device__ __forceinline__ void attn_unit(int b,int h,int qb,const bf16*Q,const bf16*__restrict__ K,const bf16*__restrict__ V,const float*__restrict__ c2g,bf16*O,int ocol0,char*shm){
  int tid=threadIdx.x; asm volatile("":"+v"(tid));
  const int lane=tid&63,r32=lane&31,hi=lane>>5; const int wid=__builtin_amdgcn_readfirstlane(tid>>6);
  const long rowbase=(long)b*SEQ; const int q0=qb*QB;
  const bf16*Qw=Q+(rowbase+q0+wid*QBLK)*DM+h*D;
  const bf16*Kh=K+rowbase*DM+h*D,*Vh=V+rowbase*DM+h*D;
  const unsigned lds0=(unsigned)(uintptr_t)shm;
  float*wsf=(float*)(shm+LDS_WS)+wid*64;
  const bf16*ksrc=Kh+(long)lane*DM+wid*8;
  const bf16*vsrc=Vh+(long)(16*(wid&3)+(lane>>2))*DM+(wid>>2)*32+(lane&3)*8;
  const unsigned kdst=lds0+LDS_K+wid*1024, vdst=lds0+LDS_V+wid*1024;
  #define DMA_K(t,slot) glds16(ksrc+(long)(t)*KVBLK*DM,(unsigned)__builtin_amdgcn_readfirstlane(kdst+(slot)))
  #define DMA_V(t,slot) glds16(vsrc+(long)(t)*KVBLK*DM,(unsigned)__builtin_amdgcn_readfirstlane(vdst+(slot)))
  const int vb0=(int)(lds0+LDS_V)+((lane>>4)&1)*32+(lane&3)*8+(4*hi+((lane&15)>>2))*64;
  const char*Kbase=shm+LDS_K; bf16x8 kf[8];
  const lds_cptr shm3=(lds_cptr)shm; const lds_cptr kp0=shm3+LDS_K+hi*1024+r32*16; const lds_cptr vp0=shm3+LDS_V+((lane>>4)&1)*32+(lane&3)*8+(4*hi+((lane&15)>>2))*64;
  const int NT=(q0+QB)/KVBLK;
  DMA_K(0,0);DMA_V(0,0);DMA_K(1,SLOTB);
  bf16x8 qr[4];
  #pragma unroll
  for(int d0=0;d0<4;++d0)qr[d0]=*reinterpret_cast<const bf16x8*>(&Qw[(long)r32*DM+d0*16+hi*8]);
  __attribute__((address_space(3))) float*cs=(__attribute__((address_space(3))) float*)((__attribute__((address_space(3))) char*)shm+LDS_C);
  { const float*cg=c2g+(size_t)(b*NHEAD+h)*SEQ; for(int i=tid;i<q0+QB;i+=NW*64)cs[i]=cg[i]; }
  float nmq=0.f,l_reg=0.f;f32x16 o[2];o[0]=f32x16{};o[1]=f32x16{};
  #define BIAS(C0,C1,t) do{ const __attribute__((address_space(3))) float*cb_=cs+(t)*KVBLK+4*hi; \
    _Pragma("unroll") for(int g_=0;g_<4;++g_){ const f32x4v ca_=*(const __attribute__((address_space(3))) f32x4v*)(cb_+8*g_), cc_=*(const __attribute__((address_space(3))) f32x4v*)(cb_+32+8*g_); \
      _Pragma("unroll") for(int j_=0;j_<4;++j_){ C0[4*g_+j_]=nmq-ca_[j_]; C1[4*g_+j_]=nmq-cc_[j_]; } } }while(0)
  const int qrel=wid*QBLK+r32;
  #define CMASK(P0,P1,t) do{int jb_=(t)-(NT-4); if(jb_>=0)cmask(P0,P1,jb_,qrel,hi);}while(0)
  bool resc=false;
  #define START(P0,P1) do{ const float rm=rowmax(P0,P1); resc=false; \
    { const float dl=rm; nmq=fsub_s(nmq,dl); \
      _Pragma("unroll") for(int r=0;r<16;++r){P0[r]=fsub_s(P0[r],dl);P1[r]=fsub_s(P1[r],dl);} } \
    _Pragma("unroll") for(int r=0;r<16;++r)P0[r]=__builtin_amdgcn_exp2f(P0[r]); }while(0)
  #define RESC() do{ if(resc){ asm volatile("s_waitcnt lgkmcnt(0)":::"memory"); \
      _Pragma("unroll") for(int d_=0;d_<2;++d_) _Pragma("unroll") for(int r=0;r<16;++r)o[d_][r]*=wsf[crow(r,hi)]; } }while(0)
  f32x16 pA0,pA1,pB0,pB1;
  int sl_prev=0,sl_cur=0,sl_next=SLOTB;
  #define ROT() do{sl_prev=sl_cur;sl_cur=sl_next;sl_next=(sl_next==(NSLOT-1)*SLOTB)?0:sl_next+SLOTB;}while(0)
  DMA_K(2,2*SLOTB);
  WAIT_BAR(3);
  nmq=cs[q0+qrel]; BIAS(pA0,pA1,0);
  qkt(pA0,pA1,Kbase,qr,r32,hi);asm volatile("s_nop 15\n\ts_nop 7":"+v"(pA0),"+v"(pA1));CMASK(pA0,pA1,0);
  START(pA0,pA1);
  _Pragma("unroll") for(int r=0;r<16;++r)pA1[r]=__builtin_amdgcn_exp2f(pA1[r]);
  WAIT_BAR(0);
  DMA_K(3,0);DMA_V(1,SLOTB);
  ROT();
  kload8(kf,kp0+sl_cur);
  WAIT_BAR(2);
  s16x4 vlo[8],vhi[8]; u32x4 pw0,pw1,pw2,pw3;
  #define PKW(P,B) cvtpk_s(P[B],P[B+1])
  #define PAF(k) __builtin_bit_cast(bf16x8,pw##k)
  #define VFR(i) (bf16x8){vlo[i][0],vlo[i][1],vlo[i][2],vlo[i][3],vhi[i][0],vhi[i][1],vhi[i][2],vhi[i][3]}
  #define PIN(x) asm volatile("":"+v"(x))
  #define MX3(a,b,c) __builtin_fmaxf(__builtin_fmaxf((a),(b)),(c))
  #define GAPA(MF,A0,A1,A2,A3,W0,W1,PW) do{ MF; sacc+=A0; sacc+=A1; sacc+=A2; sacc+=A3; PIN(sacc); W0; W1; PIN(PW); SBAR(); }while(0)
  #define EX(v) __builtin_amdgcn_exp2f(v)
  #define GAPB(MF,X,B) do{ MF; X[B]=EX(X[B]); X[B+1]=EX(X[B+1]); X[B+2]=EX(X[B+2]); X[B+3]=EX(X[B+3]); PIN(X); SBAR(); }while(0)
  #define VRD(i) do{ vlo[i]=vtr(vp_+(((i)>>2)*4096+((i)&3)*1024)); vhi[i]=vtr(vp_+(((i)>>2)*4096+((i)&3)*1024+512)); }while(0)
  #define KRD(G,j) do{ if(G){ kload2(kf,kp0+sl_next,j); SBAR(); } }while(0)
  #define STEP(C0,C1,P0,P1,t,GK,GV,GL) do{ SBAR(); BIAS(C0,C1,t); SBAR(); \
    const lds_cptr vp_=vp0+sl_prev; \
    VRD(0); SBAR(); float sacc=(P0[0]+P0[1]); \
    GAPA(C0=__builtin_amdgcn_mfma_f32_32x32x16_bf16(kf[0],qr[0],C0,0,0,0), P0[2],P0[3],P0[4],P0[5],     pw0[0]=PKW(P0,0), pw0[1]=PKW(P0,2), pw0); \
    VRD(4); SBAR(); GAPA(C1=__builtin_amdgcn_mfma_f32_32x32x16_bf16(kf[1],qr[0],C1,0,0,0), P0[6],P0[7],P0[8],P0[9],     pw0[2]=PKW(P0,4), pw0[3]=PKW(P0,6), pw0); \
    VRD(1); SBAR(); GAPA(C0=__builtin_amdgcn_mfma_f32_32x32x16_bf16(kf[2],qr[1],C0,0,0,0),   P0[10],P0[11],P0[12],P0[13], pw1[0]=PKW(P0,8), pw1[1]=PKW(P0,10), pw1); \
    VRD(5); SBAR(); GAPA(C1=__builtin_amdgcn_mfma_f32_32x32x16_bf16(kf[3],qr[1],C1,0,0,0),   P0[14],P0[15],P1[0],P1[1],   pw1[2]=PKW(P0,12),pw1[3]=PKW(P0,14), pw1); \
    VRD(2); SBAR(); GAPA(C0=__builtin_amdgcn_mfma_f32_32x32x16_bf16(kf[4],qr[2],C0,0,0,0),   P1[2],P1[3],P1[4],P1[5],     pw2[0]=PKW(P1,0), pw2[1]=PKW(P1,2), pw2); \
    VRD(6); SBAR(); GAPA(C1=__builtin_amdgcn_mfma_f32_32x32x16_bf16(kf[5],qr[2],C1,0,0,0),   P1[6],P1[7],P1[8],P1[9],     pw2[2]=PKW(P1,4), pw2[3]=PKW(P1,6), pw2); \
    VRD(3); SBAR(); GAPA(C0=__builtin_amdgcn_mfma_f32_32x32x16_bf16(kf[6],qr[3],C0,0,0,0),   P1[10],P1[11],P1[12],P1[13], pw3[0]=PKW(P1,8), pw3[1]=PKW(P1,10), pw3); \
    VRD(7); SBAR(); GAPA(C1=__builtin_amdgcn_mfma_f32_32x32x16_bf16(kf[7],qr[3],C1,0,0,0),   P1[14],P1[15],0.f,0.f,       pw3[2]=PKW(P1,12),pw3[3]=PKW(P1,14), pw3); \
    l_reg+=sacc; \
    if(GK){DMA_K((t)+3,sl_cur);} if(GV){DMA_V((t)+1,sl_next);} \
    CMASK(C0,C1,t); \
    { float a=MX3(C0[0],C0[1],C1[0]),b=MX3(C0[2],C0[3],C1[1]); a=MX3(a,C1[2],C1[3]); \
      _Pragma("unroll") for(int r=4;r<16;r+=4){a=MX3(a,C0[r],C0[r+1]);b=MX3(b,C0[r+2],C0[r+3]);a=MX3(a,C1[r],C1[r+1]);b=MX3(b,C1[r+2],C1[r+3]);} \
      float rm=__builtin_fmaxf(a,b); { auto rr=__builtin_amdgcn_permlane32_swap(__float_as_uint(rm),__float_as_uint(rm),false,false); rm=__builtin_fmaxf(__uint_as_float(rr[0]),__uint_as_float(rr[1])); } \
      resc=false; \
      if(__builtin_expect(__any(rm>(float)THRL),0)){ const float dl=__builtin_fmaxf(rm,0.f); nmq-=dl; \
        _Pragma("unroll") for(int r=0;r<16;++r){C0[r]-=dl;C1[r]-=dl;} \
        const float f=__builtin_amdgcn_exp2f(-dl); l_reg*=f; if(hi==0)wsf[r32]=f; resc=true; } } \
    SBAR(); \
    GAPB(o[0]=__builtin_amdgcn_mfma_f32_32x32x16_bf16(PAF(0),VFR(0),o[0],0,0,0), C0,0); \
    GAPB(o[1]=__builtin_amdgcn_mfma_f32_32x32x16_bf16(PAF(0),VFR(4),o[1],0,0,0), C0,4); \
    KRD(GL,0); GAPB(o[0]=__builtin_amdgcn_mfma_f32_32x32x16_bf16(PAF(1),VFR(1),o[0],0,0,0), C0,8); \
    KRD(GL,1); GAPB(o[1]=__builtin_amdgcn_mfma_f32_32x32x16_bf16(PAF(1),VFR(5),o[1],0,0,0), C0,12); \
    KRD(GL,2); GAPB(o[0]=__builtin_amdgcn_mfma_f32_32x32x16_bf16(PAF(2),VFR(2),o[0],0,0,0), C1,0); \
    KRD(GL,3); GAPB(o[1]=__builtin_amdgcn_mfma_f32_32x32x16_bf16(PAF(2),VFR(6),o[1],0,0,0), C1,4); \
    GAPB(o[0]=__builtin_amdgcn_mfma_f32_32x32x16_bf16(PAF(3),VFR(3),o[0],0,0,0), C1,8); \
    GAPB(o[1]=__builtin_amdgcn_mfma_f32_32x32x16_bf16(PAF(3),VFR(7),o[1],0,0,0), C1,12); \
    }while(0)
  int t=1;
  #undef CMASK
  #define CMASK(P0,P1,t) do{}while(0)
  for(;t+5<NT;t+=2){
    STEP(pB0,pB1,pA0,pA1,t,true,true,true);     WAIT_BAR(2); RESC(); ROT();
    STEP(pA0,pA1,pB0,pB1,t+1,true,true,true);   WAIT_BAR(2); RESC(); ROT();
  }
  #undef CMASK
  #define CMASK(P0,P1,t) do{int jb_=(t)-(NT-4); if(jb_>=0)cmask(P0,P1,jb_,qrel,hi);}while(0)
  #define ENDW(tt) do{ if((tt)+3<NT){WAIT_BAR(2);} else if((tt)+2<NT){WAIT_BAR(1);} else {WAIT_BAR(0);} }while(0)
  for(;t+1<NT;t+=2){
    STEP(pB0,pB1,pA0,pA1,t,(t+3<NT),(t+1<NT),(t+1<NT));       ENDW(t);   RESC(); ROT();
    STEP(pA0,pA1,pB0,pB1,t+1,(t+4<NT),(t+2<NT),(t+2<NT));     ENDW(t+1); RESC(); ROT();
  }
  STEP(pB0,pB1,pA0,pA1,NT-1,false,false,false); RESC();
  { float sacc=pB0[0]+pB0[1]; _Pragma("unroll") for(int r=2;r<16;++r)sacc+=pB0[r]; _Pragma("unroll") for(int r=0;r<16;++r)sacc+=pB1[r]; l_reg+=sacc;
    pw0=(u32x4){PKW(pB0,0),PKW(pB0,2),PKW(pB0,4),PKW(pB0,6)};pw1=(u32x4){PKW(pB0,8),PKW(pB0,10),PKW(pB0,12),PKW(pB0,14)};pw2=(u32x4){PKW(pB1,0),PKW(pB1,2),PKW(pB1,4),PKW(pB1,6)};pw3=(u32x4){PKW(pB1,8),PKW(pB1,10),PKW(pB1,12),PKW(pB1,14)};
    SBAR(); pv(o,vb0+sl_cur,PAF(0),PAF(1),PAF(2),PAF(3)); }
  #undef PKW
  #undef PAF
  #undef VFR
  #undef PIN
  #undef MX3
  #undef GAPA
  #undef GAPB
  #undef EX
  #undef VRD
  #undef KRD
  #undef STEP
  #undef ENDW
  {auto rr=__builtin_amdgcn_permlane32_swap(__float_as_uint(l_reg),__float_as_uint(l_reg),false,false);l_reg=__uint_as_float(rr[0])+__uint_as_float(rr[1]);}
  if(hi==0)wsf[32+r32]=l_reg;asm volatile("s_waitcnt lgkmcnt(0)":::"memory");
  float rli[16];
  #pragma unroll
  for(int r=0;r<16;++r)rli[r]=__builtin_amdgcn_rcpf(wsf[32+crow(r,hi)]);
  bf16*Ow=O+(rowbase+q0+wid*QBLK)*OPITCH+ocol0+h*D;
  { bf16*stg=(bf16*)(shm+LDS_OST)+wid*2048;
    #pragma unroll
    for(int r=0;r<16;++r){const int orow=crow(r,hi);
      #pragma unroll
      for(int d0=0;d0<2;++d0)stg[orow*64+d0*32+r32]=__float2bfloat16(o[d0][r]*rli[r]);}
    asm volatile("s_waitcnt lgkmcnt(0)":::"memory");
    #pragma unroll
    for(int i=0;i<4;++i){const int row=i*8+(lane>>3),ch=lane&7; const u32x4 v=*(const u32x4*)(stg+row*64+ch*8); ATTN_STORE16(Ow+(long)row*OPITCH+ch*8,v);} }
  asm volatile("s_waitcnt lgkmcnt(0)\n\ts_barrier":::"memory");
  #undef DMA_K
  #undef DMA_V
  #undef CMASK
  #undef START
  #undef RESC
  #undef ROT
  #undef BIAS
}
#undef SBAR
#undef WAIT_BAR
}
constexpr int NWAVES = 8;
constexpr int M_TOK = 16384, DM = 1024, SEQL = 2048, NBATCH = 8, NHD = 8, HDIM = 64, ADIM = 512, PDIM = 512, PGD_ = 128, INDIM = 2056;
constexpr int NEXP = 32, FEXP = 512, PLED = 256;
constexpr float RMS_EPS = 1e-6f, LOG2E = 1.4426950408889634f;

constexpr size_t MiB = 1u << 20, KiB = 1u << 10;
constexpr size_t WS_CTL = 0, CTL_ZERO_BYTES = 256 * KiB;
constexpr size_t WS_WIN = 1 * MiB;
constexpr size_t WS_WOUT = 5 * MiB;
constexpr size_t WS_WPG = 7 * MiB;
constexpr size_t WS_WPP = 9 * MiB;
constexpr size_t WS_WPOOL = 9 * MiB + 512 * KiB;
constexpr size_t WS_WRT = 9 * MiB + 768 * KiB;
constexpr size_t WS_WF = 10 * MiB;
constexpr size_t WS_C2 = 10 * MiB + 512 * KiB;
constexpr size_t WS_LOGF = 11 * MiB;
constexpr size_t WS_TOKPAIR = 11 * MiB + 512 * KiB;
constexpr size_t WS_LIST = 12 * MiB;
constexpr size_t WS_WL = 14 * MiB;
constexpr size_t WS_WGU = 16 * MiB;
constexpr size_t WS_WDN = 80 * MiB;
constexpr size_t WS_XN = 112 * MiB;
constexpr size_t WS_U = 144 * MiB, WS_Q = 160 * MiB, WS_K = 176 * MiB, WS_V = 192 * MiB;
constexpr size_t WS_ACT = 144 * MiB;
constexpr size_t WS_PROJ = 177 * MiB;
constexpr size_t WS_PBF = 209 * MiB;
constexpr size_t WS_MIX = 217 * MiB;
constexpr size_t WS_YP = 217 * MiB;
constexpr size_t WS_END = 281 * MiB;
constexpr int CW_TMO = 0, CW_CNT = 2048, CW_BAR = 4096;

constexpr int RING_OFF = 0, RING_BYTES = 131072;
constexpr int LDSCTL_OFF = 147456;
constexpr int LC_MISC = LDSCTL_OFF, LC_CNT = LDSCTL_OFF + 128, LC_TPRE = LDSCTL_OFF + 256, LC_COFF = LDSCTL_OFF + 512, LC_TAB = LDSCTL_OFF + 768,
              LC_HIST = LDSCTL_OFF + 1024, LC_HBASE = LDSCTL_OFF + 1152, LC_PEND = LDSCTL_OFF + 2048, LC_GIDX = LDSCTL_OFF + 4096;
constexpr int LDS_BYTES = LDSCTL_OFF + 8192;

#define GAS __attribute__((address_space(1)))
#define LAS __attribute__((address_space(3)))
typedef unsigned short bf16;
typedef unsigned v4u __attribute__((ext_vector_type(4)));
typedef unsigned v2u __attribute__((ext_vector_type(2)));
typedef float f32x4 __attribute__((ext_vector_type(4)));
typedef short bf16x8 __attribute__((ext_vector_type(8)));
typedef float f32x16 __attribute__((ext_vector_type(16)));
typedef GAS unsigned gu32;
#define RLX_AGENT __ATOMIC_RELAXED, __HIP_MEMORY_SCOPE_AGENT
#define LDS_WAIT() asm volatile("s_waitcnt lgkmcnt(0)" ::: "memory")
#define VM_WAIT() asm volatile("s_waitcnt vmcnt(0)" ::: "memory")
__device__ __forceinline__ unsigned f2bf(float f) { unsigned u = __builtin_bit_cast(unsigned, f); return (u + 0x7fffu + ((u >> 16) & 1u)) >> 16; }
__device__ __forceinline__ unsigned pk2(float lo, float hi) { return f2bf(lo) | (f2bf(hi) << 16); }
__device__ __forceinline__ float bf_lo(unsigned w) { return __builtin_bit_cast(float, w << 16); }
__device__ __forceinline__ float bf_hi(unsigned w) { return __builtin_bit_cast(float, w & 0xffff0000u); }

#define XB_TMO      128
#define XB_XCNT(j)  (256  + 64 * (j))
#define XB_XSUB(j)  (1280 + 64 * (j))
#define XB_XGEN(j)  (2304 + 64 * (j))
#define XB_TOP      3328
#define XB_TOPGEN   3392
#define XCD_BAR_WORDS 3456
#define XB_SPIN_CAP (1u << 18)
__device__ __forceinline__ unsigned xb_ld(unsigned* p)              { return __hip_atomic_load(p, __ATOMIC_RELAXED, __HIP_MEMORY_SCOPE_AGENT); }
__device__ __forceinline__ unsigned xb_add(unsigned* p, unsigned v) { return __hip_atomic_fetch_add(p, v, __ATOMIC_RELAXED, __HIP_MEMORY_SCOPE_AGENT); }
__device__ __forceinline__ unsigned xb_xcc_id() { return (unsigned)__builtin_amdgcn_s_getreg((3 << 11) | 20) & 0xFu; }
#define XB_SPIN(cond, bar) do { unsigned _sp = 0; while (cond) { __builtin_amdgcn_s_sleep(1); \
    if ((++_sp & 255u) == 0u) { if (xb_ld(&(bar)[XB_TMO])) break; if (_sp > XB_SPIN_CAP) { atomicAdd(&(bar)[XB_TMO], 1u); break; } } } } while (0)
struct XcdBarrier { unsigned* bar; unsigned x; volatile LAS unsigned* st; };
__device__ __forceinline__ XcdBarrier xcd_barrier_post(unsigned* bar, volatile LAS unsigned* st) {
    XcdBarrier b; b.bar = bar; b.x = xb_xcc_id(); b.st = st;
    if (threadIdx.x == 0) (void)xb_add(&bar[XB_XCNT(b.x)], 1u);
    return b;
}
__device__ __forceinline__ void xcd_barrier_complete(unsigned* bar, unsigned x, unsigned& nloc, unsigned& nx) {
    const unsigned G = gridDim.x * gridDim.y * gridDim.z;
    unsigned sum, cnt, mine, sp = 0u;
    for (;;) {
        sum = 0u; cnt = 0u; mine = 0u;
#pragma unroll
        for (unsigned j = 0; j < 16; ++j) { const unsigned c = xb_ld(&bar[XB_XCNT(j)]); sum += c; cnt += (c > 0u) ? 1u : 0u; mine = (j == x) ? c : mine; }
        if (sum == G) break;
        __builtin_amdgcn_s_sleep(1);
        if ((++sp & 255u) == 0u) { if (xb_ld(&bar[XB_TMO])) break; if (sp > XB_SPIN_CAP) { atomicAdd(&bar[XB_TMO], 1u); break; } }
    }
    nloc = mine > 0u ? mine : 1u; nx = cnt > 0u ? cnt : 1u;
}
__device__ __forceinline__ void xcd_barrier(const XcdBarrier& b) {
    asm volatile("s_waitcnt vmcnt(0)" ::: "memory");
    __syncthreads();
    if (threadIdx.x == 0) {
        unsigned* bar = b.bar;
        __builtin_amdgcn_s_waitcnt(0);
        unsigned nloc = b.st[0], nx = b.st[1];
        if (nloc == 0u) { xcd_barrier_complete(bar, b.x, nloc, nx); b.st[0] = nloc; b.st[1] = nx; }
        const unsigned old = xb_add(&bar[XB_XSUB(b.x)], 1u);
        const unsigned gen = old / nloc;
        if (old + 1u == (gen + 1u) * nloc) {
            __builtin_amdgcn_fence(__ATOMIC_RELEASE, "agent");
            asm volatile("s_waitcnt vmcnt(0)" ::: "memory");
            const unsigned og = xb_add(&bar[XB_TOP], 1u);
            const unsigned tg = og / nx;
            if (og + 1u == (tg + 1u) * nx) xb_add(&bar[XB_TOPGEN], 1u);
            else XB_SPIN(xb_ld(&bar[XB_TOPGEN]) == tg, bar);
            __builtin_amdgcn_fence(__ATOMIC_ACQUIRE, "agent");
            xb_add(&bar[XB_XGEN(b.x)], 1u);
            asm volatile("s_waitcnt vmcnt(0)" ::: "memory");
        } else {
            XB_SPIN(xb_ld(&bar[XB_XGEN(b.x)]) == gen, bar);
            __builtin_amdgcn_fence(__ATOMIC_ACQUIRE, "agent");
            asm volatile("s_waitcnt vmcnt(0)" ::: "memory");
        }
    }
    __syncthreads();
}

namespace pg8 {
struct EpiSplit4 {
    static constexpr bool PERM = true;
    bf16_t* O; size_t stride; float qscale;
    __device__ __forceinline__ void operator()(const f32x4 (&acc)[2][2][4][2], const Unit& u, int wr, int wc, int fr, int fq) const {
        const int row0 = u.pm * BM + wr * 64 + fr; const int t = u.pn >> 1; bf16_t* base = O + (size_t)t * stride; const float sc = (t == 1) ? qscale : 1.f;
        const int col0 = (u.pn & 1) * BM + wc * 32 + 8 * fq;
#pragma unroll
        for (int ai = 0; ai < 2; ++ai)
#pragma unroll
            for (int m = 0; m < 4; ++m) { bf16_t* rowp = base + (size_t)(row0 + ai * HALF + m * 16) * 512 + col0;
#pragma unroll
                for (int bj = 0; bj < 2; ++bj) { const f32x4 v0 = acc[ai][bj][m][0] * sc, v1 = acc[ai][bj][m][1] * sc;
                    u32x4 w; w.x = cvt_pk_bf16(v0[0], v0[1]); w.y = cvt_pk_bf16(v0[2], v0[3]); w.z = cvt_pk_bf16(v1[0], v1[1]); w.w = cvt_pk_bf16(v1[2], v1[3]);
                    *(u32x4*)(rowp + bj * HALF) = w; } }
    }
};
struct EpiBf16Plain {
    static constexpr bool PERM = true;
    bf16_t* O; int ldc;
    __device__ __forceinline__ void operator()(const f32x4 (&acc)[2][2][4][2], const Unit& u, int wr, int wc, int fr, int fq) const {
        const int row0 = u.pm * BM + wr * 64 + fr, col0 = u.pn * BM + wc * 32 + 8 * fq;
#pragma unroll
        for (int ai = 0; ai < 2; ++ai)
#pragma unroll
            for (int m = 0; m < 4; ++m) { bf16_t* rowp = O + (size_t)(row0 + ai * HALF + m * 16) * ldc + col0;
#pragma unroll
                for (int bj = 0; bj < 2; ++bj) { const f32x4 v0 = acc[ai][bj][m][0], v1 = acc[ai][bj][m][1];
                    u32x4 w; w.x = cvt_pk_bf16(v0[0], v0[1]); w.y = cvt_pk_bf16(v0[2], v0[3]); w.z = cvt_pk_bf16(v1[0], v1[1]); w.w = cvt_pk_bf16(v1[2], v1[3]);
                    *(u32x4*)(rowp + bj * HALF) = w; } }
    }
};
struct EpiResF32 {
    static constexpr bool PERM = false;
    const float* X; float* H;
    __device__ __forceinline__ void operator()(const f32x4 (&acc)[2][2][4][2], const Unit& u, int wr, int wc, int fr, int fq) const {
        const int row0 = u.pm * BM + wr * 64 + fr, col0 = u.pn * BM + wc * 32 + 4 * fq;
#pragma unroll
        for (int ai = 0; ai < 2; ++ai)
#pragma unroll
            for (int m = 0; m < 4; ++m) { const size_t off = (size_t)(row0 + ai * HALF + m * 16) * 1024 + col0;
#pragma unroll
                for (int bj = 0; bj < 2; ++bj)
#pragma unroll
                    for (int n = 0; n < 2; ++n) *(f32x4*)(H + off + bj * HALF + n * 16) = *(const f32x4*)(X + off + bj * HALF + n * 16) + acc[ai][bj][m][n]; }
    }
};
__device__ __forceinline__ float silu_f(float g) { return g * __builtin_amdgcn_rcpf(1.f + __builtin_amdgcn_exp2f(-g * 1.4426950408889634f)); }
__device__ __forceinline__ float sigmoid_f(float g) { return __builtin_amdgcn_rcpf(1.f + __builtin_amdgcn_exp2f(-g * 1.4426950408889634f)); }
struct EpiMoeAct {
    static constexpr bool PERM = true;
    bf16_t* ACT; const float* WL;
    __device__ __forceinline__ void operator()(const f32x4 (&acc)[2][2][4][2], const Unit& u, int wr, int wc, int fr, int fq) const {
        const int col0 = u.pn * HALF + wc * 32 + 8 * fq;
#pragma unroll
        for (int ai = 0; ai < 2; ++ai)
#pragma unroll
            for (int m = 0; m < 4; ++m) { const int r = ai * HALF + wr * 64 + m * 16 + fr;
                if (r < u.x1) { const float w = WL[u.x2 + r]; const f32x4 g0 = acc[ai][0][m][0], g1 = acc[ai][0][m][1], u0 = acc[ai][1][m][0], u1 = acc[ai][1][m][1];
                    u32x4 o; o.x = cvt_pk_bf16(silu_f(g0[0]) * u0[0] * w, silu_f(g0[1]) * u0[1] * w); o.y = cvt_pk_bf16(silu_f(g0[2]) * u0[2] * w, silu_f(g0[3]) * u0[3] * w);
                    o.z = cvt_pk_bf16(silu_f(g1[0]) * u1[0] * w, silu_f(g1[1]) * u1[1] * w); o.w = cvt_pk_bf16(silu_f(g1[2]) * u1[2] * w, silu_f(g1[3]) * u1[3] * w);
                    *(u32x4*)(ACT + (size_t)(u.x0 + r) * 512 + col0) = o; } }
    }
};
struct EpiMoeDown {
    static constexpr bool PERM = true;
    bf16_t* YP;
    __device__ __forceinline__ void operator()(const f32x4 (&acc)[2][2][4][2], const Unit& u, int wr, int wc, int fr, int fq) const {
        const int col0 = u.pn * BM + wc * 32 + 8 * fq;
#pragma unroll
        for (int ai = 0; ai < 2; ++ai)
#pragma unroll
            for (int m = 0; m < 4; ++m) { const int r = ai * HALF + wr * 64 + m * 16 + fr;
                if (r < u.x1) { bf16_t* rowp = YP + (size_t)(u.x0 + r) * 1024 + col0;
#pragma unroll
                    for (int bj = 0; bj < 2; ++bj) { const f32x4 v0 = acc[ai][bj][m][0], v1 = acc[ai][bj][m][1];
                        u32x4 w; w.x = cvt_pk_bf16(v0[0], v0[1]); w.y = cvt_pk_bf16(v0[2], v0[3]); w.z = cvt_pk_bf16(v1[0], v1[1]); w.w = cvt_pk_bf16(v1[2], v1[3]);
                        *(u32x4*)(rowp + bj * HALF) = w; } } }
    }
};
struct EpiPle {
    static constexpr bool PERM = true;
    const float* H; float* HO; const bf16_t* PROJ;
    __device__ __forceinline__ void operator()(const f32x4 (&acc)[2][2][4][2], const Unit& u, int wr, int wc, int fr, int fq) const {
        const int row0 = u.pm * BM + wr * 64 + fr, col0 = u.pn * BM + wc * 32 + 8 * fq;
#pragma unroll
        for (int ai = 0; ai < 2; ++ai)
#pragma unroll
            for (int m = 0; m < 4; ++m) { const size_t off = (size_t)(row0 + ai * HALF + m * 16) * 1024 + col0;
#pragma unroll
                for (int bj = 0; bj < 2; ++bj) { const u32x4 pw = *(const u32x4*)(PROJ + off + bj * HALF);
                    const f32x4 h0 = *(const f32x4*)(H + off + bj * HALF), h1 = *(const f32x4*)(H + off + bj * HALF + 4); const f32x4 a0 = acc[ai][bj][m][0], a1 = acc[ai][bj][m][1];
                    f32x4 o0, o1;
                    o0[0] = h0[0] + sigmoid_f(a0[0]) * __builtin_bit_cast(float, pw.x << 16); o0[1] = h0[1] + sigmoid_f(a0[1]) * __builtin_bit_cast(float, pw.x & 0xffff0000u);
                    o0[2] = h0[2] + sigmoid_f(a0[2]) * __builtin_bit_cast(float, pw.y << 16); o0[3] = h0[3] + sigmoid_f(a0[3]) * __builtin_bit_cast(float, pw.y & 0xffff0000u);
                    o1[0] = h1[0] + sigmoid_f(a1[0]) * __builtin_bit_cast(float, pw.z << 16); o1[1] = h1[1] + sigmoid_f(a1[1]) * __builtin_bit_cast(float, pw.z & 0xffff0000u);
                    o1[2] = h1[2] + sigmoid_f(a1[2]) * __builtin_bit_cast(float, pw.w << 16); o1[3] = h1[3] + sigmoid_f(a1[3]) * __builtin_bit_cast(float, pw.w & 0xffff0000u);
                    *(f32x4*)(HO + off + bj * HALF) = o0; *(f32x4*)(HO + off + bj * HALF + 4) = o1; }
                asm volatile("" ::: "memory"); }
    }
};
struct MoeSched {
    const PG8_LAS int* tab; const char* A; const char* Bt; size_t estride, tstep; int Kb2; bool gather;
    __device__ __forceinline__ bool next(int i, Unit& u) const {
        if (i >= 4) return false;
        if (__builtin_amdgcn_readfirstlane(tab[i * 8 + 0]) == 0) return false;
        const int e = __builtin_amdgcn_readfirstlane(tab[i * 8 + 1]), mt = __builtin_amdgcn_readfirstlane(tab[i * 8 + 2]), pn = __builtin_amdgcn_readfirstlane(tab[i * 8 + 3]);
        const int rowbase = __builtin_amdgcn_readfirstlane(tab[i * 8 + 4]), nvalid = __builtin_amdgcn_readfirstlane(tab[i * 8 + 5]);
        u.pm = mt; u.pn = pn; u.b = Bt + (size_t)e * estride + (size_t)pn * tstep; u.a = gather ? A : A + (size_t)rowbase * Kb2;
        u.x0 = rowbase; u.x1 = nvalid; u.x2 = e * 16384 + mt * 256; u.x3 = e; return true;
    }
};
}
struct Args { const float* in[20]; float* out; unsigned char* ws; int ph_lo, ph_hi, li, pad; };
constexpr int NPHASE = 10;
#ifndef MK_REPEAT
#define MK_REPEAT -1
#endif
#define REPS(k) ((MK_REPEAT == (k)) ? 2 : 1)
#ifndef MK_PHMASK
#define MK_PHMASK 0x3ff
#endif

__device__ __forceinline__ float wave_sum(float v) {
#pragma unroll
    for (int o = 1; o < 64; o <<= 1) v += __shfl_xor(v, o);
    return v;
}
__device__ __forceinline__ void p0_transpose_item(const float* W, int ldw, int K, bf16* WT, int k0, int n0, int drow0, LAS float* scr, int lane) {
    float tv[32];
#pragma unroll
    for (int i = 0; i < 32; ++i) { const int kk = 2 * i + (lane >> 5); tv[i] = W[(size_t)(k0 + kk) * ldw + n0 + (lane & 31)]; }
#pragma unroll
    for (int i = 0; i < 32; ++i) { const int kk = 2 * i + (lane >> 5); scr[kk * 33 + (lane & 31)] = tv[i]; }
    LDS_WAIT(); asm volatile("" ::: "memory");
    const int c = lane & 7;
#pragma unroll
    for (int j = 0; j < 4; ++j) { const int n = (lane >> 3) + 8 * j; const LAS float* s = scr + (8 * c) * 33 + n;
        v4u o; o.x = pk2(s[0 * 33], s[1 * 33]); o.y = pk2(s[2 * 33], s[3 * 33]); o.z = pk2(s[4 * 33], s[5 * 33]); o.w = pk2(s[6 * 33], s[7 * 33]);
        *(GAS v4u*)(WT + (size_t)(drow0 + n) * K + k0 + 8 * c) = o; }
    LDS_WAIT(); asm volatile("" ::: "memory");
}

#define RS_STEP(P_, H_) { const bool up = (lane & (H_)) != 0; _Pragma("unroll") for (int i = 0; i < (H_); ++i) { const float keep = up ? P_[i + (H_)] : P_[i], send = up ? P_[i] : P_[i + (H_)]; P_[i] = keep + __shfl_xor(send, (H_)); } }
#define ROUTE_2ROWS(PA_, PB_, RQ_, MTOK_) do { \
    const bool hiH = lane >= 32; float q[32]; \
    _Pragma("unroll") for (int i = 0; i < 32; ++i) { const float keep = hiH ? PB_[i] : PA_[i], send = hiH ? PA_[i] : PB_[i]; q[i] = keep + __shfl_xor(send, 32); } \
    RS_STEP(q, 16) RS_STEP(q, 8) RS_STEP(q, 4) RS_STEP(q, 2) RS_STEP(q, 1) \
    float g4[4]; \
    _Pragma("unroll") for (int i = 0; i < 4; ++i) { const float keep = hiH ? PB_[32 + i] : PA_[32 + i], send = hiH ? PA_[32 + i] : PB_[32 + i]; g4[i] = keep + __shfl_xor(send, 32); } \
    RS_STEP(g4, 2) RS_STEP(g4, 1) \
    float gl = g4[0]; gl += __shfl_xor(gl, 4); gl += __shfl_xor(gl, 8); gl += __shfl_xor(gl, 16); \
    const float elog = q[0] + brt, glog = gl + bgr; const int hb = lane & 32; \
    const float g0 = __shfl(glog, hb + 0), g1 = __shfl(glog, hb + 1), g2 = __shfl(glog, hb + 2), g3 = __shfl(glog, hb + 3); \
    int gi = 0; float gm = g0; if (g1 > gm) { gm = g1; gi = 1; } if (g2 > gm) { gm = g2; gi = 2; } if (g3 > gm) { gm = g3; gi = 3; } \
    const float gw_ = 1.f / (__expf(g0 - gm) + __expf(g1 - gm) + __expf(g2 - gm) + __expf(g3 - gm)); \
    float sel[8]; \
    _Pragma("unroll") for (int j = 0; j < 8; ++j) sel[j] = __shfl(elog, hb + gi * 8 + j); \
    int i1 = 0; float v1 = sel[0]; \
    _Pragma("unroll") for (int j = 1; j < 8; ++j) if (sel[j] > v1) { v1 = sel[j]; i1 = j; } \
    int i2 = -1; float v2 = -INFINITY; \
    _Pragma("unroll") for (int j = 0; j < 8; ++j) if (j != i1 && sel[j] > v2) { v2 = sel[j]; i2 = j; } \
    const float e2 = __expf(v2 - v1); const float w1 = gw_ / (1.f + e2), w2 = gw_ * e2 / (1.f + e2); \
    if ((lane & 31) == 0) { const int ex1 = gi * 8 + i1, ex2 = gi * 8 + i2, rq_ = (RQ_) + (lane >> 5), mt_ = (MTOK_) + (lane >> 5); \
        const int p1 = __hip_atomic_fetch_add(&hist[ex1], 1, __ATOMIC_RELAXED, __HIP_MEMORY_SCOPE_WORKGROUP), p2 = __hip_atomic_fetch_add(&hist[ex2], 1, __ATOMIC_RELAXED, __HIP_MEMORY_SCOPE_WORKGROUP); \
        pend[(rq_ * 2 + 0) * 4 + 0] = ex1; pend[(rq_ * 2 + 0) * 4 + 1] = p1; pend[(rq_ * 2 + 0) * 4 + 2] = __builtin_bit_cast(int, w1); pend[(rq_ * 2 + 0) * 4 + 3] = mt_; \
        pend[(rq_ * 2 + 1) * 4 + 0] = ex2; pend[(rq_ * 2 + 1) * 4 + 1] = p2; pend[(rq_ * 2 + 1) * 4 + 2] = __builtin_bit_cast(int, w2); pend[(rq_ * 2 + 1) * 4 + 3] = mt_; } \
} while (0)

__global__ void __launch_bounds__(NWAVES * 64, 2) mk_fwd(Args args) {
    extern __shared__ __attribute__((aligned(16))) unsigned char lds[];
    LAS unsigned char* L = (LAS unsigned char*)lds;
    const int tid = threadIdx.x, lane = tid & 63, wave = __builtin_amdgcn_readfirstlane(tid >> 6);
    const int G = gridDim.x; const int bx = blockIdx.x; const int vcu = (G % 8 == 0) ? (bx % 8) * (G / 8) + bx / 8 : bx;
    unsigned char* ws = args.ws;
    gu32* ctl = (gu32*)(ws + WS_CTL);
    const float* x = args.in[0]; const float* p_in = args.in[1]; const float* g_mix = args.in[2]; const float* w_in = args.in[3]; const float* b_f = args.in[4];
    const float* w_pool = args.in[5]; const float* s_pool = args.in[6]; const float* w_out = args.in[7]; const float* g_ffn = args.in[8]; const float* w_grp = args.in[9];
    const float* b_grp = args.in[10]; const float* w_rt = args.in[11]; const float* b_rt = args.in[12]; const float* w_e_gate = args.in[13]; const float* w_e_up = args.in[14];
    const float* w_e_down = args.in[15]; const float* g_ple = args.in[16]; const float* w_ple_gate = args.in[17]; const float* w_ple_proj = args.in[18]; const float* g_final = args.in[19];
    float* H = args.out;
    bf16* WIN = (bf16*)(ws + WS_WIN); bf16* WOUT = (bf16*)(ws + WS_WOUT); bf16* WPG = (bf16*)(ws + WS_WPG); bf16* WPP = (bf16*)(ws + WS_WPP); bf16* WPOOL = (bf16*)(ws + WS_WPOOL);
    float* WRT = (float*)(ws + WS_WRT); float* WF = (float*)(ws + WS_WF); float* C2G = (float*)(ws + WS_C2); float* LOGF = (float*)(ws + WS_LOGF);
    int* TOKPAIR = (int*)(ws + WS_TOKPAIR); int* LIST = (int*)(ws + WS_LIST); float* WL = (float*)(ws + WS_WL);
    bf16* WGU = (bf16*)(ws + WS_WGU); bf16* WDN = (bf16*)(ws + WS_WDN); bf16* XN = (bf16*)(ws + WS_XN);
    bf16* UB = (bf16*)(ws + WS_U); bf16* QB_ = (bf16*)(ws + WS_Q); bf16* KB = (bf16*)(ws + WS_K); bf16* VB = (bf16*)(ws + WS_V);
    bf16* ACT = (bf16*)(ws + WS_ACT); bf16* PROJ = (bf16*)(ws + WS_PROJ); bf16* PBF = (bf16*)(ws + WS_PBF); bf16* MIX = (bf16*)(ws + WS_MIX); bf16* YP = (bf16*)(ws + WS_YP);
    unsigned* GCNT = (unsigned*)(ctl + CW_CNT);

    for (int u = tid; u < (LDS_BYTES - LDSCTL_OFF) / 4; u += NWAVES * 64) ((LAS unsigned*)(L + LDSCTL_OFF))[u] = 0u;
    __syncthreads();
    volatile LAS unsigned* MISC = (volatile LAS unsigned*)(L + LC_MISC);
    XcdBarrier bar = xcd_barrier_post((unsigned*)(ctl + CW_BAR) + args.li * XCD_BAR_WORDS, MISC + 8);
    const int lo = args.ph_lo, hi = args.ph_hi;
#define IN(k) (lo <= (k) && (k) < hi)
#define BOTH(k) (IN(k) && IN((k) + 1))
#define GRID_BAR() xcd_barrier(bar)
    const int gw = vcu * NWAVES + wave, NGW = G * NWAVES;

    if (((MK_PHMASK >> 0) & 1) && IN(0)) {
#pragma unroll 1
      for (int rep_ = 0; rep_ < REPS(0); ++rep_) {
        LAS float* scr = (LAS float*)(L + RING_OFF + wave * 16384);
        constexpr int I_IN = 16 * 64, I_OUT = 16 * 32, I_PG = 16 * 32, I_PP = 4 * 32, I_POOL = 4 * 2 * 4, I_G = 32 * 16 * 16, I_U = I_G, I_D = 32 * 8 * 32;
        constexpr int NITEMS = I_IN + I_OUT + I_PG + I_PP + I_POOL + I_G + I_U + I_D;
        for (int it = gw; it < NITEMS; it += NGW) {
            int r = it;
            if (r < I_IN) { const int kb = r / 64, nb = r % 64; p0_transpose_item(w_in, INDIM, 1024, WIN, 64 * kb, 32 * nb, 32 * nb, scr, lane); continue; } r -= I_IN;
            if (r < I_OUT) { const int kb = r / 32, nb = r % 32; p0_transpose_item(w_out, 1024, 1024, WOUT, 64 * kb, 32 * nb, 32 * nb, scr, lane); continue; } r -= I_OUT;
            if (r < I_PG) { const int kb = r / 32, nb = r % 32; p0_transpose_item(w_ple_gate, 1024, 1024, WPG, 64 * kb, 32 * nb, 32 * nb, scr, lane); continue; } r -= I_PG;
            if (r < I_PP) { const int kb = r / 32, nb = r % 32; p0_transpose_item(w_ple_proj, 1024, 256, WPP, 64 * kb, 32 * nb, 32 * nb, scr, lane); continue; } r -= I_PP;
            if (r < I_POOL) { const int g = r / 8, q = r % 8, kb = q / 4, nb = q % 4; p0_transpose_item(w_pool + (size_t)g * 128 * 128, 128, 128, WPOOL + (size_t)g * 128 * 128, 64 * kb, 32 * nb, 32 * nb, scr, lane); continue; } r -= I_POOL;
            if (r < I_G) { const int e = r / 256, q = r % 256, kb = q / 16, nb = q % 16, n0 = 32 * nb; p0_transpose_item(w_e_gate + (size_t)e * 1024 * 512, 512, 1024, WGU + (size_t)e * 1024 * 1024, 64 * kb, n0, (n0 >> 7) * 256 + (n0 & 127), scr, lane); continue; } r -= I_G;
            if (r < I_U) { const int e = r / 256, q = r % 256, kb = q / 16, nb = q % 16, n0 = 32 * nb; p0_transpose_item(w_e_up + (size_t)e * 1024 * 512, 512, 1024, WGU + (size_t)e * 1024 * 1024, 64 * kb, n0, (n0 >> 7) * 256 + 128 + (n0 & 127), scr, lane); continue; } r -= I_U;
            { const int e = r / 256, q = r % 256, kb = q / 32, nb = q % 32; p0_transpose_item(w_e_down + (size_t)e * 512 * 1024, 1024, 512, WDN + (size_t)e * 1024 * 512, 64 * kb, 32 * nb, 32 * nb, scr, lane); }
        }
        for (int i = gw * 64 + lane; i < 36 * 1024; i += NGW * 64) { const int o = i >> 10, k = i & 1023; WRT[i] = (o < 32) ? w_rt[k * 32 + o] : w_grp[k * 4 + (o - 32)]; }
        __syncthreads();
        LAS float* wf = (LAS float*)(L + RING_OFF);
        for (int i = tid; i < 8 * 1024; i += NWAVES * 64) { const int k = i >> 3, h = i & 7; wf[h * 1024 + k] = w_in[(size_t)k * INDIM + 2048 + h]; }
        __syncthreads();
        f32x4 gm[4];
#pragma unroll
        for (int j = 0; j < 4; ++j) gm[j] = ((const GAS f32x4*)g_mix)[lane + 64 * j];
        const float bfl = b_f[lane & 7];
#pragma unroll 1
        for (int m = 2 * gw; m < M_TOK; m += 2 * NGW) {
            const GAS f32x4* xr = (const GAS f32x4*)(x + (size_t)m * DM) + lane;
            f32x4 va[4], vb[4]; float s2a = 0.f, s2b = 0.f;
#pragma unroll
            for (int j = 0; j < 4; ++j) { va[j] = xr[64 * j]; vb[j] = xr[256 + 64 * j]; }
#pragma unroll
            for (int j = 0; j < 4; ++j) { s2a += (va[j].x * va[j].x + va[j].y * va[j].y) + (va[j].z * va[j].z + va[j].w * va[j].w); s2b += (vb[j].x * vb[j].x + vb[j].y * vb[j].y) + (vb[j].z * vb[j].z + vb[j].w * vb[j].w); }
            const float rsa = 1.f / sqrtf(wave_sum(s2a) * (1.f / DM) + RMS_EPS), rsb = 1.f / sqrtf(wave_sum(s2b) * (1.f / DM) + RMS_EPS);
#pragma unroll
            for (int j = 0; j < 4; ++j) { va[j] = va[j] * rsa * gm[j]; vb[j] = vb[j] * rsb * gm[j]; }
            GAS unsigned long long* o8 = (GAS unsigned long long*)(XN + (size_t)m * DM) + lane;
#pragma unroll
            for (int j = 0; j < 4; ++j) { o8[64 * j] = (unsigned long long)pk2(va[j].x, va[j].y) | ((unsigned long long)pk2(va[j].z, va[j].w) << 32);
                o8[256 + 64 * j] = (unsigned long long)pk2(vb[j].x, vb[j].y) | ((unsigned long long)pk2(vb[j].z, vb[j].w) << 32); }
            float fla = 0.f, flb = 0.f;
#pragma unroll
            for (int h = 0; h < 8; ++h) { float a = 0.f, b = 0.f;
#pragma unroll
                for (int j = 0; j < 4; ++j) { const f32x4 w = *(const LAS f32x4*)(wf + h * 1024 + 4 * lane + 256 * j);
                    a += (va[j].x * w.x + va[j].y * w.y) + (va[j].z * w.z + va[j].w * w.w); b += (vb[j].x * w.x + vb[j].y * w.y) + (vb[j].z * w.z + vb[j].w * w.w); }
                a = wave_sum(a); b = wave_sum(b); if ((lane & 7) == h) { fla = a; flb = b; } }
            if (lane < 16) { const float xl = ((lane < 8) ? fla : flb) + bfl; const float lf = fminf(xl, 0.f) - log1pf(__expf(-fabsf(xl)));
                const int mm = m + (lane >> 3); const int b = mm / SEQL, sq = mm % SEQL; LOGF[(size_t)(b * NHD + (lane & 7)) * SEQL + sq] = lf; }
        }
        if (rep_ + 1 < REPS(0)) GRID_BAR();
      }
        if (BOTH(0)) GRID_BAR();
    }

    if (((MK_PHMASK >> 1) & 1) && IN(1)) {
#pragma unroll 1
      for (int rep_ = 0; rep_ < REPS(1); ++rep_) {
        for (int bh = vcu; bh < NBATCH * NHD; bh += G) {
            const f32x4 v = ((const GAS f32x4*)(LOGF + (size_t)bh * SEQL))[tid];
            const float s1 = v.x, s2 = s1 + v.y, s3 = s2 + v.z, s4 = s3 + v.w;
            float incl = s4;
#pragma unroll
            for (int o = 1; o < 64; o <<= 1) { const float t = __shfl_up(incl, o); if (lane >= o) incl += t; }
            if (lane == 63) MISC[16 + wave] = __builtin_bit_cast(unsigned, incl);
            __syncthreads();
            float base = incl - s4;
            for (int w = 0; w < wave; ++w) base += __builtin_bit_cast(float, (unsigned)MISC[16 + w]);
            f32x4 o; o.x = (base + s1) * LOG2E; o.y = (base + s2) * LOG2E; o.z = (base + s3) * LOG2E; o.w = (base + s4) * LOG2E;
            ((GAS f32x4*)(C2G + (size_t)bh * SEQL))[tid] = o;
            __syncthreads();
        }
        pg8::StaticSched S; S.init(XN, WIN, M_TOK, 2048, 1024, G, bx);
        pg8::EpiSplit4 E{(pg8::bf16_t*)UB, (size_t)M_TOK * 512, fox::C2};
        pg8::gemm_phase<pg8::EpiSplit4, pg8::StaticSched, false, true>(L + RING_OFF, 1024, S, E, nullptr);
        if (rep_ + 1 < REPS(1)) GRID_BAR();
      }
        if (BOTH(1)) GRID_BAR();
    }

    if (((MK_PHMASK >> 2) & 1) && IN(2)) {
#pragma unroll 1
      for (int rep_ = 0; rep_ < REPS(2); ++rep_) {
        for (int un = vcu; un < NBATCH * NHD * 4; un += G) {
            const int bh = un >> 2, s = un & 3;
#pragma unroll 1
            for (int i = 0; i < 2; ++i) { const int qb = (i == 0) ? (7 - s) : s;
#ifdef MK_ATTN_SIMPLE
                fox::attn_unit(bh / NHD, bh % NHD, qb, (const fox::bf16*)QB_, (const fox::bf16*)KB, (const fox::bf16*)VB, C2G, (fox::bf16*)MIX, 512, (char*)lds + RING_OFF); }
#else
                fox2::attn_unit<8>(bh / NHD, bh % NHD, qb, (const fox2::bf16*)QB_, (const fox2::bf16*)KB, (const fox2::bf16*)VB, C2G, (fox2::bf16*)MIX, 512, (char*)lds + RING_OFF); }
#endif
        }
        for (int un = vcu; un < 64 * 4; un += G) {
            int tid = threadIdx.x; asm volatile("" : "+v"(tid));
            const int lane = tid & 63;
            const int pm = un >> 2, g = un & 3, W = 2 << g;
            constexpr int RS = 272;
            LAS unsigned char* At = L + RING_OFF; LAS unsigned char* Bt = L + RING_OFF + 256 * RS;
            for (int i = tid; i < 128 * 16; i += NWAVES * 64) { const int n = i >> 4, c = i & 15; *(LAS v4u*)(Bt + n * RS + c * 16) = *(const GAS v4u*)(WPOOL + (size_t)g * 128 * 128 + n * 128 + c * 8); }
            { const int c = tid & 15, rg = tid >> 4; const int r0 = rg * 8; const int s0 = (pm & 7) * 256 + r0;
              const bf16* ub = UB + (size_t)(pm * 256 + r0) * 512 + g * 128 + c * 8;
              float run[8];
#pragma unroll
              for (int j = 0; j < 8; ++j) run[j] = 0.f;
              for (int j = 1; j < W; ++j) { if (s0 - j >= 0) { const v4u w = *(const GAS v4u*)(ub - (size_t)j * 512);
                  run[0] += bf_lo(w.x); run[1] += bf_hi(w.x); run[2] += bf_lo(w.y); run[3] += bf_hi(w.y); run[4] += bf_lo(w.z); run[5] += bf_hi(w.z); run[6] += bf_lo(w.w); run[7] += bf_hi(w.w); } }
#pragma unroll
              for (int i = 0; i < 8; ++i) {
                  const v4u w = *(const GAS v4u*)(ub + (size_t)i * 512);
                  float cur[8] = {bf_lo(w.x), bf_hi(w.x), bf_lo(w.y), bf_hi(w.y), bf_lo(w.z), bf_hi(w.z), bf_lo(w.w), bf_hi(w.w)};
#pragma unroll
                  for (int j = 0; j < 8; ++j) run[j] += cur[j];
                  const int sp = s0 + i; const float inv = 1.f / (float)((sp + 1 < W) ? sp + 1 : W);
                  v4u o; o.x = pk2(run[0] * inv - cur[0], run[1] * inv - cur[1]); o.y = pk2(run[2] * inv - cur[2], run[3] * inv - cur[3]);
                  o.z = pk2(run[4] * inv - cur[4], run[5] * inv - cur[5]); o.w = pk2(run[6] * inv - cur[6], run[7] * inv - cur[7]);
                  *(LAS v4u*)(At + (r0 + i) * RS + c * 16) = o;
                  if (sp - W + 1 >= 0) { const v4u z = *(const GAS v4u*)(ub + (long)(i - W + 1) * 512);
                      run[0] -= bf_lo(z.x); run[1] -= bf_hi(z.x); run[2] -= bf_lo(z.y); run[3] -= bf_hi(z.y); run[4] -= bf_lo(z.z); run[5] -= bf_hi(z.z); run[6] -= bf_lo(z.w); run[7] -= bf_hi(z.w); }
              } }
            __syncthreads();
            { const int r32 = lane & 31, hh = lane >> 5; f32x16 acc[4];
#pragma unroll
              for (int nb = 0; nb < 4; ++nb) acc[nb] = f32x16{};
#pragma unroll
              for (int ks = 0; ks < 8; ++ks) { const bf16x8 a = *(const LAS bf16x8*)(At + (wave * 32 + r32) * RS + (16 * ks + 8 * hh) * 2);
#pragma unroll
                  for (int nb = 0; nb < 4; ++nb) { const bf16x8 b = *(const LAS bf16x8*)(Bt + (nb * 32 + r32) * RS + (16 * ks + 8 * hh) * 2);
                      acc[nb] = __builtin_amdgcn_mfma_f32_32x32x16_bf16(a, b, acc[nb], 0, 0, 0); } }
#pragma unroll
              for (int nb = 0; nb < 4; ++nb) { const int n = g * 128 + nb * 32 + r32; const float sc = s_pool[n];
#pragma unroll
                  for (int r = 0; r < 16; ++r) { const int row = pm * 256 + wave * 32 + (r & 3) + 8 * (r >> 2) + 4 * hh; MIX[(size_t)row * 1024 + n] = (bf16)f2bf(acc[nb][r] * sc); } } }
            __syncthreads();
        }
        if (rep_ + 1 < REPS(2)) GRID_BAR();
      }
        if (BOTH(2)) GRID_BAR();
    }

    if (((MK_PHMASK >> 3) & 1) && IN(3)) {
#pragma unroll 1
      for (int rep_ = 0; rep_ < REPS(3); ++rep_) {
        pg8::StaticSched S; S.init(MIX, WOUT, M_TOK, 1024, 1024, G, bx);
        pg8::EpiResF32 E{x, H};
        pg8::gemm_phase<pg8::EpiResF32, pg8::StaticSched, false, true>(L + RING_OFF, 1024, S, E, nullptr);
        if (rep_ + 1 < REPS(3)) GRID_BAR();
      }
        if (BOTH(3)) GRID_BAR();
    }

    if (((MK_PHMASK >> 4) & 1) && IN(4)) {
#pragma unroll 1
      for (int dry = REPS(4) - 1; dry >= 0; --dry) {
        bf16* XNd = dry ? (bf16*)(ws + WS_U) : XN; int* LISTd = dry ? (int*)(ws + WS_K) : LIST; float* WLd = dry ? (float*)(ws + WS_K + 4 * MiB) : WL; int* TOKd = dry ? (int*)(ws + WS_K + 8 * MiB) : TOKPAIR;
        unsigned* GCNTd = dry ? GCNT + 64 : GCNT;
        LAS float* wl = (LAS float*)(L + 0);
        for (int i = tid; i < 36 * 256; i += NWAVES * 64) ((LAS f32x4*)wl)[i] = ((const GAS f32x4*)WRT)[i];
        LAS int* hist = (LAS int*)(L + LC_HIST); LAS int* hbase = (LAS int*)(L + LC_HBASE); LAS int* pend = (LAS int*)(L + LC_PEND);
        if (tid < 32) hist[tid] = 0;
        __syncthreads();
        f32x4 gf[4];
#pragma unroll
        for (int j = 0; j < 4; ++j) gf[j] = ((const GAS f32x4*)g_ffn)[lane + 64 * j];
        const float brt = b_rt[lane & 31], bgr = b_grp[lane & 3];
        const int rows_per_cu = M_TOK / G;
        f32x4 va[4], vb[4];
        { const GAS f32x4* hr = (const GAS f32x4*)(H + (size_t)(vcu * rows_per_cu + 2 * wave) * DM) + lane;
#pragma unroll
          for (int j = 0; j < 4; ++j) { va[j] = hr[64 * j]; vb[j] = hr[256 + 64 * j]; } }
#pragma unroll 1
        for (int rr = 2 * wave; rr < rows_per_cu; rr += 2 * NWAVES) {
            const int m = vcu * rows_per_cu + rr;
            float s2a = 0.f, s2b = 0.f;
#pragma unroll
            for (int j = 0; j < 4; ++j) { s2a += (va[j].x * va[j].x + va[j].y * va[j].y) + (va[j].z * va[j].z + va[j].w * va[j].w); s2b += (vb[j].x * vb[j].x + vb[j].y * vb[j].y) + (vb[j].z * vb[j].z + vb[j].w * vb[j].w); }
            const float rsa = 1.f / sqrtf(wave_sum(s2a) * (1.f / DM) + RMS_EPS), rsb = 1.f / sqrtf(wave_sum(s2b) * (1.f / DM) + RMS_EPS);
#pragma unroll
            for (int j = 0; j < 4; ++j) { va[j] = va[j] * rsa * gf[j]; vb[j] = vb[j] * rsb * gf[j]; }
            { GAS unsigned long long* o8 = (GAS unsigned long long*)(XNd + (size_t)m * DM) + lane;
#pragma unroll
              for (int j = 0; j < 4; ++j) { o8[64 * j] = (unsigned long long)pk2(va[j].x, va[j].y) | ((unsigned long long)pk2(va[j].z, va[j].w) << 32);
                  o8[256 + 64 * j] = (unsigned long long)pk2(vb[j].x, vb[j].y) | ((unsigned long long)pk2(vb[j].z, vb[j].w) << 32); } }
            float pa[36], pb[36];
#pragma unroll
            for (int o = 0; o < 36; ++o) { float a = 0.f, b = 0.f;
#pragma unroll
                for (int j = 0; j < 4; ++j) { const f32x4 w = *(const LAS f32x4*)(wl + o * 1024 + 4 * lane + 256 * j);
                    a += (va[j].x * w.x + va[j].y * w.y) + (va[j].z * w.z + va[j].w * w.w); b += (vb[j].x * w.x + vb[j].y * w.y) + (vb[j].z * w.z + vb[j].w * w.w); }
                pa[o] = a; pb[o] = b; if ((o & 3) == 3) asm volatile("" ::: "memory"); }
            { const int rn = (rr + 2 * NWAVES < rows_per_cu) ? rr + 2 * NWAVES : rr; const GAS f32x4* hr = (const GAS f32x4*)(H + (size_t)(vcu * rows_per_cu + rn) * DM) + lane;
#pragma unroll
              for (int j = 0; j < 4; ++j) { va[j] = hr[64 * j]; vb[j] = hr[256 + 64 * j]; } }
            ROUTE_2ROWS(pa, pb, rr, m);
        }
        __syncthreads();
        if (tid < 32) { const int c = hist[tid]; hbase[tid] = c ? (int)__hip_atomic_fetch_add(GCNTd + tid, (unsigned)c, RLX_AGENT) : 0; }
        __syncthreads();
        if (tid < rows_per_cu * 2) { const int e = pend[tid * 4 + 0], pos = hbase[e] + pend[tid * 4 + 1], m = pend[tid * 4 + 3];
            LISTd[e * M_TOK + pos] = m; WLd[e * M_TOK + pos] = __builtin_bit_cast(float, pend[tid * 4 + 2]);
            TOKd[m * 4 + (tid & 1) * 2 + 0] = e; TOKd[m * 4 + (tid & 1) * 2 + 1] = pos; }
        if (dry) GRID_BAR();
      }
        if (BOTH(4)) GRID_BAR();
    }

    if (IN(5) || IN(6) || IN(7)) {
        LAS int* lcnt = (LAS int*)(L + LC_CNT); LAS int* ltpre = (LAS int*)(L + LC_TPRE); LAS int* lcoff = (LAS int*)(L + LC_COFF); LAS int* tab = (LAS int*)(L + LC_TAB); LAS int* gidx = (LAS int*)(L + LC_GIDX);
        if (tid == 0) { int tp = 0, co = 0; for (int e = 0; e < NEXP; ++e) { const int c = (int)__hip_atomic_load(GCNT + e, RLX_AGENT); lcnt[e] = c; ltpre[e] = tp; lcoff[e] = co; tp += (c + 255) >> 8; co += c; } ltpre[NEXP] = tp; lcoff[NEXP] = co; }
        __syncthreads();
        if (tid < 4) { const int nwg = ltpre[NEXP] * 4; const long Lq = (long)tid * G + bx; int valid = 0, e = 0, mt = 0, pn = 0, rowbase = 0, nvalid = 0;
            if (Lq < nwg) { int wgid = (int)Lq; { const int q = nwg / 8, r = nwg % 8, xcd = wgid % 8, off = wgid / 8; wgid = (xcd < r ? xcd * (q + 1) : r * (q + 1) + (xcd - r) * q) + off; }
                while (e < NEXP - 1 && 4 * ltpre[e + 1] <= wgid) ++e;
                const int Te = ltpre[e + 1] - ltpre[e], loc = wgid - 4 * ltpre[e]; mt = loc % Te; pn = loc / Te; valid = 1;
                rowbase = lcoff[e] + mt * 256; nvalid = lcnt[e] - mt * 256; if (nvalid > 256) nvalid = 256; }
            tab[tid * 8 + 0] = valid; tab[tid * 8 + 1] = e; tab[tid * 8 + 2] = mt; tab[tid * 8 + 3] = pn; tab[tid * 8 + 4] = rowbase; tab[tid * 8 + 5] = nvalid; }
        __syncthreads();
    }
    if (((MK_PHMASK >> 5) & 1) && IN(5)) {
#pragma unroll 1
      for (int rep_ = 0; rep_ < REPS(5); ++rep_) {
        LAS int* tab = (LAS int*)(L + LC_TAB); LAS int* gidx = (LAS int*)(L + LC_GIDX);
        for (int i = tid; i < 3 * 256; i += NWAVES * 64) { const int ui = i >> 8, r = i & 255; int row = 0;
            if (tab[ui * 8 + 0] && r < tab[ui * 8 + 5]) row = LIST[tab[ui * 8 + 1] * M_TOK + tab[ui * 8 + 2] * 256 + r];
            gidx[i] = row; }
        __syncthreads();
        pg8::MoeSched S{tab, (const char*)XN, (const char*)WGU, (size_t)1024 * 1024 * 2, (size_t)256 * 1024 * 2, 2048, true};
        pg8::EpiMoeAct E{(pg8::bf16_t*)ACT, WL};
        pg8::gemm_phase<pg8::EpiMoeAct, pg8::MoeSched, true, true>(L + RING_OFF, 1024, S, E, gidx);
        if (rep_ + 1 < REPS(5)) GRID_BAR();
      }
        if (BOTH(5)) GRID_BAR();
    }
    if (((MK_PHMASK >> 6) & 1) && IN(6)) {
#pragma unroll 1
      for (int rep_ = 0; rep_ < REPS(6); ++rep_) {
        LAS int* tab = (LAS int*)(L + LC_TAB);
        pg8::MoeSched S{tab, (const char*)ACT, (const char*)WDN, (size_t)1024 * 512 * 2, (size_t)256 * 512 * 2, 1024, false};
        pg8::EpiMoeDown E{(pg8::bf16_t*)YP};
        pg8::gemm_phase<pg8::EpiMoeDown, pg8::MoeSched, false, true>(L + RING_OFF, 512, S, E, nullptr);
        if (rep_ + 1 < REPS(6)) GRID_BAR();
      }
        if (BOTH(6)) GRID_BAR();
    }

    if (((MK_PHMASK >> 7) & 1) && IN(7)) {
#pragma unroll 1
      for (int dry = REPS(7) - 1; dry >= 0; --dry) {
        float* Hd = dry ? (float*)(ws + WS_WGU) : H; bf16* XNd = dry ? (bf16*)(ws + WS_WDN) : XN;
        LAS int* lcoff = (LAS int*)(L + LC_COFF);
        f32x4 gp[4];
#pragma unroll
        for (int j = 0; j < 4; ++j) gp[j] = ((const GAS f32x4*)g_ple)[lane + 64 * j];
        typedef int i32x4 __attribute__((ext_vector_type(4)));
        i32x4 tka = *(const GAS i32x4*)(TOKPAIR + (size_t)(2 * gw) * 4), tkb = *(const GAS i32x4*)(TOKPAIR + (size_t)(2 * gw + 1) * 4);
#pragma unroll 1
        for (int m = 2 * gw; m < M_TOK; m += 2 * NGW) {
            const int sa0 = lcoff[tka.x] + tka.y, sa1 = lcoff[tka.z] + tka.w, sb0 = lcoff[tkb.x] + tkb.y, sb1 = lcoff[tkb.z] + tkb.w;
            { const int mn = (m + 2 * NGW < M_TOK) ? m + 2 * NGW : m; tka = *(const GAS i32x4*)(TOKPAIR + (size_t)mn * 4); tkb = *(const GAS i32x4*)(TOKPAIR + (size_t)(mn + 1) * 4); }
            const GAS f32x4* hr = (const GAS f32x4*)(H + (size_t)m * DM) + lane;
            const GAS v2u* ya0 = (const GAS v2u*)(YP + (size_t)sa0 * DM) + lane; const GAS v2u* ya1 = (const GAS v2u*)(YP + (size_t)sa1 * DM) + lane;
            const GAS v2u* yb0 = (const GAS v2u*)(YP + (size_t)sb0 * DM) + lane; const GAS v2u* yb1 = (const GAS v2u*)(YP + (size_t)sb1 * DM) + lane;
            f32x4 va[4], vb[4]; v2u a0[4], a1[4], b0[4], b1[4];
#pragma unroll
            for (int j = 0; j < 4; ++j) { va[j] = hr[64 * j]; vb[j] = hr[256 + 64 * j]; a0[j] = ya0[64 * j]; a1[j] = ya1[64 * j]; b0[j] = yb0[64 * j]; b1[j] = yb1[64 * j]; }
            const f32x4 pva = ((const GAS f32x4*)(p_in + (size_t)m * PLED))[lane], pvb = ((const GAS f32x4*)(p_in + (size_t)(m + 1) * PLED))[lane];
            float s2a = 0.f, s2b = 0.f;
            GAS f32x4* ho = (GAS f32x4*)(Hd + (size_t)m * DM) + lane;
#pragma unroll
            for (int j = 0; j < 4; ++j) {
                va[j].x += bf_lo(a0[j].x) + bf_lo(a1[j].x); va[j].y += bf_hi(a0[j].x) + bf_hi(a1[j].x); va[j].z += bf_lo(a0[j].y) + bf_lo(a1[j].y); va[j].w += bf_hi(a0[j].y) + bf_hi(a1[j].y);
                vb[j].x += bf_lo(b0[j].x) + bf_lo(b1[j].x); vb[j].y += bf_hi(b0[j].x) + bf_hi(b1[j].x); vb[j].z += bf_lo(b0[j].y) + bf_lo(b1[j].y); vb[j].w += bf_hi(b0[j].y) + bf_hi(b1[j].y);
                ho[64 * j] = va[j]; ho[256 + 64 * j] = vb[j];
                s2a += (va[j].x * va[j].x + va[j].y * va[j].y) + (va[j].z * va[j].z + va[j].w * va[j].w); s2b += (vb[j].x * vb[j].x + vb[j].y * vb[j].y) + (vb[j].z * vb[j].z + vb[j].w * vb[j].w); }
            const float rsa = 1.f / sqrtf(wave_sum(s2a) * (1.f / DM) + RMS_EPS), rsb = 1.f / sqrtf(wave_sum(s2b) * (1.f / DM) + RMS_EPS);
            GAS unsigned long long* o8 = (GAS unsigned long long*)(XNd + (size_t)m * DM) + lane;
#pragma unroll
            for (int j = 0; j < 4; ++j) { const f32x4 ta = va[j] * rsa * gp[j], tb = vb[j] * rsb * gp[j];
                o8[64 * j] = (unsigned long long)pk2(ta.x, ta.y) | ((unsigned long long)pk2(ta.z, ta.w) << 32); o8[256 + 64 * j] = (unsigned long long)pk2(tb.x, tb.y) | ((unsigned long long)pk2(tb.z, tb.w) << 32); }
            GAS unsigned long long* po = (GAS unsigned long long*)(PBF + (size_t)m * PLED) + lane;
            po[0] = (unsigned long long)pk2(pva.x, pva.y) | ((unsigned long long)pk2(pva.z, pva.w) << 32); po[64] = (unsigned long long)pk2(pvb.x, pvb.y) | ((unsigned long long)pk2(pvb.z, pvb.w) << 32);
        }
        if (dry) GRID_BAR();
      }
        if (BOTH(7)) GRID_BAR();
    }

    if (((MK_PHMASK >> 8) & 1) && IN(8)) {
#pragma unroll 1
      for (int dry = REPS(8) - 1; dry >= 0; --dry) {
#ifndef MK_NO_P8A
        { pg8::StaticSched S; S.init(PBF, WPP, M_TOK, 1024, 256, G, bx);
          pg8::EpiBf16Plain E{(pg8::bf16_t*)PROJ, 1024};
          pg8::gemm_phase<pg8::EpiBf16Plain, pg8::StaticSched, false, true>(L + RING_OFF, 256, S, E, nullptr); }
#endif
        VM_WAIT();
#ifndef MK_NO_P8B
        { pg8::StaticSched S; S.init(XN, WPG, M_TOK, 1024, 1024, G, bx);
          pg8::EpiPle E{H, dry ? (float*)(ws + WS_WGU) : H, (const pg8::bf16_t*)PROJ};
          pg8::gemm_phase<pg8::EpiPle, pg8::StaticSched, false, true>(L + RING_OFF, 1024, S, E, nullptr); }
#endif
        if (dry) GRID_BAR();
      }
        if (BOTH(8)) GRID_BAR();
    }

    if (((MK_PHMASK >> 9) & 1) && IN(9)) {
#pragma unroll 1
      for (int dry = REPS(9) - 1; dry >= 0; --dry) {
        float* Hd = dry ? (float*)(ws + WS_WGU) : H;
        f32x4 gq[4];
#pragma unroll
        for (int j = 0; j < 4; ++j) gq[j] = ((const GAS f32x4*)g_final)[lane + 64 * j];
#pragma unroll 1
        for (int m = 2 * gw; m < M_TOK; m += 2 * NGW) {
            const GAS f32x4* hr = (const GAS f32x4*)(H + (size_t)m * DM) + lane;
            f32x4 va[4], vb[4]; float s2a = 0.f, s2b = 0.f;
#pragma unroll
            for (int j = 0; j < 4; ++j) { va[j] = hr[64 * j]; vb[j] = hr[256 + 64 * j]; }
#pragma unroll
            for (int j = 0; j < 4; ++j) { s2a += (va[j].x * va[j].x + va[j].y * va[j].y) + (va[j].z * va[j].z + va[j].w * va[j].w); s2b += (vb[j].x * vb[j].x + vb[j].y * vb[j].y) + (vb[j].z * vb[j].z + vb[j].w * vb[j].w); }
            const float rsa = 1.f / sqrtf(wave_sum(s2a) * (1.f / DM) + RMS_EPS), rsb = 1.f / sqrtf(wave_sum(s2b) * (1.f / DM) + RMS_EPS);
            GAS f32x4* ho = (GAS f32x4*)(Hd + (size_t)m * DM) + lane;
#pragma unroll
            for (int j = 0; j < 4; ++j) { ho[64 * j] = va[j] * rsa * gq[j]; ho[256 + 64 * j] = vb[j] * rsb * gq[j]; }
        }
        if (dry) GRID_BAR();
      }
    }
#undef IN
#undef BOTH
#undef GRID_BAR
}
#ifndef MK_HYBRID
#define MK_HYBRID 0
#endif
#ifndef MK_PER_PHASE
#define MK_PER_PHASE 0
#endif
extern "C" void kernel_launch(void* const* d_in, const int* in_sizes, int n_in, void* d_out, int out_size, void* d_ws, size_t ws_size, hipStream_t stream) {
    static int grid = 0;
    if (grid == 0) {
        if (n_in != 20 || in_sizes[0] != M_TOK * DM || out_size != M_TOK * DM || ws_size < WS_END) { fprintf(stderr, "kernel_launch: unexpected shapes / workspace (%d inputs, ws %zu, need %zu); nothing launched\n", n_in, ws_size, (size_t)WS_END); grid = -1; return; }
        int dev = 0, cus = 0, per_cu = 0;
        if (hipGetDevice(&dev) != hipSuccess || hipDeviceGetAttribute(&cus, hipDeviceAttributeMultiprocessorCount, dev) != hipSuccess) { grid = -1; return; }
        if (hipFuncSetAttribute((const void*)mk_fwd, hipFuncAttributeMaxDynamicSharedMemorySize, LDS_BYTES) != hipSuccess) { fprintf(stderr, "kernel_launch: hipFuncSetAttribute(%d B LDS) failed\n", LDS_BYTES); grid = -1; return; }
        if (hipOccupancyMaxActiveBlocksPerMultiprocessor(&per_cu, (const void*)mk_fwd, NWAVES * 64, LDS_BYTES) != hipSuccess || per_cu < 1) { fprintf(stderr, "kernel_launch: occupancy query says %d blocks per CU; nothing launched\n", per_cu); (void)hipGetLastError(); grid = -1; return; }
        grid = cus;
        if (grid != 256) { fprintf(stderr, "kernel_launch: built for 256 CUs, found %d; nothing launched\n", cus); grid = -1; return; }
    }
    if (grid < 0) return;
    (void)hipMemsetAsync((char*)d_ws + WS_CTL, 0, CTL_ZERO_BYTES, stream);
    Args a{};
    for (int i = 0; i < 20; ++i) a.in[i] = (const float*)d_in[i];
    a.out = (float*)d_out; a.ws = (unsigned char*)d_ws;
    const int nmega = MK_HYBRID ? MK_HYBRID : NPHASE;
#if MK_PER_PHASE
    for (int ph = 0; ph < nmega; ++ph) { a.ph_lo = ph; a.ph_hi = ph + 1; a.li = ph; hipLaunchKernelGGL(mk_fwd, dim3(grid), dim3(NWAVES * 64), LDS_BYTES, stream, a); }
#else
    a.ph_lo = 0; a.ph_hi = nmega; a.li = 0;
    hipLaunchKernelGGL(mk_fwd, dim3(grid), dim3(NWAVES * 64), LDS_BYTES, stream, a);
#endif
#if MK_HYBRID
    {
        using namespace v1;
        const float* x = (const float*)d_in[0];      const float* p = (const float*)d_in[1];
        const float* g_ffn = (const float*)d_in[8];  const float* w_grp = (const float*)d_in[9];
        const float* b_grp = (const float*)d_in[10]; const float* w_rt = (const float*)d_in[11];
        const float* b_rt = (const float*)d_in[12];  const float* w_e_gate = (const float*)d_in[13];
        const float* w_e_up = (const float*)d_in[14]; const float* w_e_down = (const float*)d_in[15];
        const float* g_ple = (const float*)d_in[16]; const float* w_ple_gate = (const float*)d_in[17];
        const float* w_ple_proj = (const float*)d_in[18]; const float* g_final = (const float*)d_in[19];
        float* out = (float*)d_out; unsigned char* ws = (unsigned char*)d_ws; (void)x;
        float* Z0 = (float*)ws; float* Z1 = (float*)(ws + 64 * MiB); float* A = (float*)(ws + 136 * MiB); float* Dd = (float*)(ws + 200 * MiB);
        unsigned char* misc = ws + 232 * MiB;
        int* cnt = (int*)(misc + 1 * MiB); int* off = cnt + 64;
        float* lg = (float*)(misc + 1 * MiB + 4096); float* le = lg + NTOK * NG; int* tokpair = (int*)(le + NTOK * NE);
        int* list = (int*)(misc + 4 * MiB); float* wl = (float*)(misc + 6 * MiB);
        if (MK_HYBRID <= 4) {
            (void)hipMemsetAsync(cnt, 0, 512, stream);
            hipLaunchKernelGGL(rmsnorm_k, dim3(NTOK), dim3(256), 0, stream, out, g_ffn, A);
            sgemm(stream, A, D_MODEL, w_grp, NG, lg, NG, NTOK, NG, D_MODEL);
            sgemm(stream, A, D_MODEL, w_rt, NE, le, NE, NTOK, NE, D_MODEL);
            hipLaunchKernelGGL(router_select_k, dim3(NTOK / 256), dim3(256), 0, stream, lg, le, b_grp, b_rt, cnt, list, wl, tokpair);
            hipLaunchKernelGGL(offsets_k, dim3(1), dim3(64), 0, stream, cnt, off);
            float* Hg = Z0; float* Hu = Z1; float* Y = Z1;
            sgemm(stream, A, D_MODEL, w_e_gate, DEXP, Hg, DEXP, NTOK, DEXP, D_MODEL, nullptr, nullptr, 0, cnt, off, list, NTOK, (size_t)D_MODEL * DEXP, NE);
            sgemm(stream, A, D_MODEL, w_e_up, DEXP, Hu, DEXP, NTOK, DEXP, D_MODEL, nullptr, nullptr, 0, cnt, off, list, NTOK, (size_t)D_MODEL * DEXP, NE);
            hipLaunchKernelGGL(moe_act_k, dim3(NTOK * DEXP / 256, NE), dim3(256), 0, stream, Hg, Hu, cnt, off, wl);
            int* slotlist = (int*)Dd;
            hipLaunchKernelGGL(slotlist_k, dim3(NTOK / 256, NE), dim3(256), 0, stream, cnt, off, slotlist);
            sgemm(stream, Hg, DEXP, w_e_down, D_MODEL, Y, D_MODEL, NTOK, D_MODEL, DEXP, nullptr, nullptr, 0, cnt, off, slotlist, NTOK, (size_t)DEXP * D_MODEL, NE);
            hipLaunchKernelGGL(moe_combine_k, dim3(NTOK * D_MODEL / 256), dim3(256), 0, stream, out, Y, off, tokpair);
        }
        if (MK_HYBRID <= 8) {
            hipLaunchKernelGGL(rmsnorm_k, dim3(NTOK), dim3(256), 0, stream, out, g_ple, Z0);
            float* Gt = Z1; float* Pj = Z1 + (size_t)NTOK * D_MODEL;
            sgemm(stream, Z0, D_MODEL, w_ple_gate, D_MODEL, Gt, D_MODEL, NTOK, D_MODEL, D_MODEL);
            sgemm(stream, p, PLE_DIM, w_ple_proj, D_MODEL, Pj, D_MODEL, NTOK, D_MODEL, PLE_DIM);
            hipLaunchKernelGGL(ple_combine_k, dim3(NTOK * D_MODEL / 256), dim3(256), 0, stream, out, Gt, Pj);
        }
        hipLaunchKernelGGL(rmsnorm_k, dim3(NTOK), dim3(256), 0, stream, out, g_final, out);
    }
#endif
}
```
